# Optimizing an MI355X kernel written in HIP

```python
import functools
import jax, jax.numpy as jnp
from jax import lax
import numpy as np


D_MODEL = 1024
BATCH = 2
SEQ = 8192
DEPTH = 4
DEC_BATCH = 32
DEC_SEQ = 16
PAST_LEN = 1024

CHUNK = 64
N_PREV_CHUNKS = 8
BAND = (N_PREV_CHUNKS + 1) * CHUNK
CACHE_A = min(N_PREV_CHUNKS * CHUNK, PAST_LEN)
D_MIX = D_MODEL
HEAD_DIM = 64
A_HEADS = 8
A_HEAD_DIM = HEAD_DIM
D_A = A_HEADS * A_HEAD_DIM
D_B = D_MIX // 4
D_C = D_MIX // 4
N_MIX_HEADS = D_MIX // HEAD_DIM
CONV_W = 3
POOL_WINDOWS = (2, 4, 8, 16)
POOL_GROUP = D_C // len(POOL_WINDOWS)
POOL_HIST = max(POOL_WINDOWS) - 1
REL_CLIP = 128
X_HEADS = 4
X_HEAD_DIM = D_MODEL // X_HEADS
N_MEM = 256
D_FF = 2816
D_IN = 3 * D_A + 3 * D_B + D_C
SPLITS = (D_A, 2 * D_A, 3 * D_A, 3 * D_A + D_B, 3 * D_A + 2 * D_B, 3 * D_A + 3 * D_B)
EPS = 1e-6
NEG = -1e30

kernel_name = 'hybrid_streaming_encoder_step'


def rmsnorm(x, g):
    xf = x.astype(jnp.float32)
    y = xf * lax.rsqrt(jnp.mean(xf * xf, axis=-1, keepdims=True) + EPS)
    return (y * g.astype(jnp.float32)).astype(x.dtype)


def head_norm(x, g):
    b, t, _ = x.shape
    xf = x.astype(jnp.float32).reshape(b, t, N_MIX_HEADS, HEAD_DIM)
    y = xf * lax.rsqrt(jnp.mean(xf * xf, axis=-1, keepdims=True) + EPS)
    return (y.reshape(b, t, D_MIX) * g.astype(jnp.float32)).astype(x.dtype)


def swiglu(h, w_gate, w_up, w_down):
    return (jax.nn.silu(h @ w_gate) * (h @ w_up)) @ w_down


def band_attention(q, k, v, rel, valid, rel_bias):
    s = jnp.einsum('bcqhd,bckhd->bchqk', q, k).astype(jnp.float32) * (A_HEAD_DIM ** -0.5)
    idx = jnp.clip(rel, -REL_CLIP, REL_CLIP) + REL_CLIP
    s = s + rel_bias.astype(jnp.float32)[:, idx][None, None]
    s = jnp.where(valid[None, :, None, None, :], s, NEG)
    p = jax.nn.softmax(s, axis=-1).astype(v.dtype)
    return jnp.einsum('bchqk,bckhd->bcqhd', p, v)


def attn_prompt(q, k, v, rel_bias):
    b, t, h, d = q.shape
    nc = t // CHUNK
    pad = N_PREV_CHUNKS * CHUNK
    k_full = jnp.pad(k, ((0, 0), (pad, 0), (0, 0), (0, 0)))
    v_full = jnp.pad(v, ((0, 0), (pad, 0), (0, 0), (0, 0)))

    def band(a):
        a = a.reshape(b, nc + N_PREV_CHUNKS, CHUNK, h, d)
        return jnp.concatenate([a[:, j:j + nc] for j in range(N_PREV_CHUNKS + 1)], axis=2)

    k_pos = (jnp.arange(nc)[:, None] - N_PREV_CHUNKS) * CHUNK + jnp.arange(BAND)[None, :]
    rel = pad + jnp.arange(CHUNK)[:, None] - jnp.arange(BAND)[None, :]
    out = band_attention(q.reshape(b, nc, CHUNK, h, d), band(k_full), band(v_full), rel, k_pos >= 0, rel_bias)
    return out.reshape(b, t, h * d), k_full[:, -CACHE_A:], v_full[:, -CACHE_A:]


def attn_sample(q, k, v, rel_bias, cache_k, cache_v):
    b, t, h, d = q.shape
    k_full = jnp.concatenate([cache_k.astype(k.dtype), k], axis=1)
    v_full = jnp.concatenate([cache_v.astype(v.dtype), v], axis=1)
    n_keys = CACHE_A + t
    rel = CACHE_A + jnp.arange(t)[:, None] - jnp.arange(n_keys)[None, :]
    valid = jnp.ones((1, n_keys), dtype=bool)
    out = band_attention(q[:, None], k_full[:, None], v_full[:, None], rel, valid, rel_bias)[:, 0]
    return out.reshape(b, t, h * d), k_full[:, -CACHE_A:], v_full[:, -CACHE_A:]


def short_conv(u, hist, w):
    t = u.shape[1]
    uf = jnp.concatenate([hist.astype(u.dtype), u], axis=1)
    y = uf[:, 0:t] * w[0]
    for i in range(1, CONV_W):
        y = y + uf[:, i:i + t] * w[i]
    return y, uf[:, -(CONV_W - 1):]


def multi_pool(u, hist, start_pos):
    t = u.shape[1]
    uf = jnp.concatenate([hist.astype(u.dtype), u], axis=1)
    cs = jnp.pad(jnp.cumsum(uf.astype(jnp.float32), axis=1), ((0, 0), (1, 0), (0, 0)))
    pos = start_pos + jnp.arange(t)
    hi = POOL_HIST + 1
    outs = []
    for g, w in enumerate(POOL_WINDOWS):
        sl = slice(g * POOL_GROUP, (g + 1) * POOL_GROUP)
        win_sum = cs[:, hi:hi + t, sl] - cs[:, hi - w:hi - w + t, sl]
        cnt = jnp.minimum(w, pos + 1).astype(jnp.float32)[None, :, None]
        outs.append(win_sum / cnt)
    pooled = jnp.concatenate(outs, axis=-1) - u.astype(jnp.float32)
    return pooled.astype(u.dtype), uf[:, -POOL_HIST:]


def memory_kv(mem, g_mem, w_xk, w_xv):
    b = mem.shape[0]
    mn = rmsnorm(mem, g_mem)
    mk = (mn @ w_xk).reshape(b, N_MEM, X_HEADS, X_HEAD_DIM)
    mv = (mn @ w_xv).reshape(b, N_MEM, X_HEADS, X_HEAD_DIM)
    return mk, mv


def cross_attn(h, mem_k, mem_v, w_xq, w_xo):
    b, t, _ = h.shape
    q = (h @ w_xq).reshape(b, t, X_HEADS, X_HEAD_DIM)
    s = jnp.einsum('bthd,bmhd->bhtm', q, mem_k.astype(h.dtype)).astype(jnp.float32) * (X_HEAD_DIM ** -0.5)
    p = jax.nn.softmax(s, axis=-1).astype(h.dtype)
    o = jnp.einsum('bhtm,bmhd->bthd', p, mem_v.astype(h.dtype)).reshape(b, t, D_MODEL)
    return o @ w_xo


def trunk_layer(x, start_pos, attn_fn, conv_hist, pool_hist, mem_k, mem_v,
                g_ffn1, w_ffn1_gate, w_ffn1_up, w_ffn1_down, g_mix, w_in, rel_bias, conv_w,
                pool_w, pool_scale, g_heads, w_out, g_xattn, w_xq, w_xo,
                g_ffn2, w_ffn2_gate, w_ffn2_up, w_ffn2_down):
    b, t, _ = x.shape
    x = x + 0.5 * swiglu(rmsnorm(x, g_ffn1), w_ffn1_gate, w_ffn1_up, w_ffn1_down)
    z = rmsnorm(x, g_mix) @ w_in
    q, k, v, bg, cg, hc, up = jnp.split(z, SPLITS, axis=-1)
    shp = (b, t, A_HEADS, A_HEAD_DIM)
    a_out, new_k, new_v = attn_fn(q.reshape(shp), k.reshape(shp), v.reshape(shp), rel_bias)
    conv_y, new_conv = short_conv(cg * hc, conv_hist, conv_w)
    b_out = bg * conv_y
    pooled, new_pool = multi_pool(up, pool_hist, start_pos)
    c_out = jnp.einsum('btgc,gcd->btgd', pooled.reshape(b, t, len(POOL_WINDOWS), POOL_GROUP), pool_w)
    c_out = c_out.reshape(b, t, D_C) * pool_scale
    mix = head_norm(jnp.concatenate([a_out, b_out, c_out], axis=-1), g_heads)
    x = x + mix @ w_out
    x = x + cross_attn(rmsnorm(x, g_xattn), mem_k, mem_v, w_xq, w_xo)
    x = x + 0.5 * swiglu(rmsnorm(x, g_ffn2), w_ffn2_gate, w_ffn2_up, w_ffn2_down)
    return x, new_k, new_v, new_conv, new_pool


def setup_inputs(seed: int = 0) -> dict:
    key = jax.random.key(seed)
    keys = iter(jax.random.split(key, 40))
    f32 = jnp.float32

    def nrm(shape, scale):
        return jax.random.normal(next(keys), shape, f32) * scale

    def gain(shape, s=0.05):
        return 1.0 + jax.random.normal(next(keys), shape, f32) * s

    return {
        'x_prompt': nrm((BATCH, SEQ, D_MODEL), 1.0),
        'x_sample': nrm((DEC_BATCH, DEC_SEQ, D_MODEL), 1.0),
        'mem_prompt': nrm((BATCH, N_MEM, D_MODEL), 1.0),
        'cache_attn_k': nrm((DEPTH, DEC_BATCH, CACHE_A, A_HEADS, A_HEAD_DIM), 1.0),
        'cache_attn_v': nrm((DEPTH, DEC_BATCH, CACHE_A, A_HEADS, A_HEAD_DIM), 1.0),
        'state_conv': nrm((DEPTH, DEC_BATCH, CONV_W - 1, D_B), 1.0),
        'state_pool': nrm((DEPTH, DEC_BATCH, POOL_HIST, D_C), 1.0),
        'cache_mem_k': nrm((DEPTH, DEC_BATCH, N_MEM, X_HEADS, X_HEAD_DIM), 1.0),
        'cache_mem_v': nrm((DEPTH, DEC_BATCH, N_MEM, X_HEADS, X_HEAD_DIM), 1.0),
        'g_ffn1': gain((DEPTH, D_MODEL)),
        'w_ffn1_gate': nrm((DEPTH, D_MODEL, D_FF), D_MODEL ** -0.5),
        'w_ffn1_up': nrm((DEPTH, D_MODEL, D_FF), D_MODEL ** -0.5),
        'w_ffn1_down': nrm((DEPTH, D_FF, D_MODEL), D_FF ** -0.5),
        'g_mix': gain((DEPTH, D_MODEL)),
        'w_in': nrm((DEPTH, D_MODEL, D_IN), D_MODEL ** -0.5),
        'rel_bias': nrm((DEPTH, A_HEADS, 2 * REL_CLIP + 1), 0.5),
        'conv_w': nrm((DEPTH, CONV_W, D_B), 0.5),
        'pool_w': nrm((DEPTH, len(POOL_WINDOWS), POOL_GROUP, POOL_GROUP), POOL_GROUP ** -0.5),
        'pool_scale': gain((DEPTH, D_C), 0.1),
        'g_heads': gain((DEPTH, D_MIX)),
        'w_out': nrm((DEPTH, D_MIX, D_MODEL), D_MIX ** -0.5),
        'g_xattn': gain((DEPTH, D_MODEL)),
        'g_mem': gain((DEPTH, D_MODEL)),
        'w_xq': nrm((DEPTH, D_MODEL, D_MODEL), D_MODEL ** -0.5),
        'w_xk': nrm((DEPTH, D_MODEL, D_MODEL), D_MODEL ** -0.5),
        'w_xv': nrm((DEPTH, D_MODEL, D_MODEL), D_MODEL ** -0.5),
        'w_xo': nrm((DEPTH, D_MODEL, D_MODEL), D_MODEL ** -0.5),
        'g_ffn2': gain((DEPTH, D_MODEL)),
        'w_ffn2_gate': nrm((DEPTH, D_MODEL, D_FF), D_MODEL ** -0.5),
        'w_ffn2_up': nrm((DEPTH, D_MODEL, D_FF), D_MODEL ** -0.5),
        'w_ffn2_down': nrm((DEPTH, D_FF, D_MODEL), D_FF ** -0.5),
        'g_final': gain((D_MODEL,)),
    }


def reference(x_prompt, x_sample, mem_prompt, cache_attn_k, cache_attn_v, state_conv, state_pool,
              cache_mem_k, cache_mem_v, g_ffn1, w_ffn1_gate, w_ffn1_up, w_ffn1_down, g_mix, w_in,
              rel_bias, conv_w, pool_w, pool_scale, g_heads, w_out, g_xattn, g_mem, w_xq, w_xk, w_xv,
              w_xo, g_ffn2, w_ffn2_gate, w_ffn2_up, w_ffn2_down, g_final):
    stacked = (g_ffn1, w_ffn1_gate, w_ffn1_up, w_ffn1_down, g_mix, w_in, rel_bias, conv_w,
               pool_w, pool_scale, g_heads, w_out, g_xattn, w_xq, w_xo,
               g_ffn2, w_ffn2_gate, w_ffn2_up, w_ffn2_down)

    bp = x_prompt.shape[0]
    xp = x_prompt
    pk, pv, pc, pp, pmk, pmv = [], [], [], [], [], []
    for l in range(DEPTH):
        lw = [w[l] for w in stacked]
        mk, mv = memory_kv(mem_prompt, g_mem[l], w_xk[l], w_xv[l])
        conv_hist = jnp.zeros((bp, CONV_W - 1, D_B), x_prompt.dtype)
        pool_hist = jnp.zeros((bp, POOL_HIST, D_C), x_prompt.dtype)
        xp, nk, nv, nc, npl = trunk_layer(xp, 0, attn_prompt, conv_hist, pool_hist, mk, mv, *lw)
        pk.append(nk); pv.append(nv); pc.append(nc); pp.append(npl); pmk.append(mk); pmv.append(mv)
    y_prompt = rmsnorm(xp, g_final)

    xs = x_sample
    sk, sv, sc, sp = [], [], [], []
    for l in range(DEPTH):
        lw = [w[l] for w in stacked]
        attn_fn = functools.partial(attn_sample, cache_k=cache_attn_k[l], cache_v=cache_attn_v[l])
        xs, nk, nv, nc, npl = trunk_layer(xs, PAST_LEN, attn_fn, state_conv[l], state_pool[l],
                                          cache_mem_k[l], cache_mem_v[l], *lw)
        sk.append(nk); sv.append(nv); sc.append(nc); sp.append(npl)
    y_sample = rmsnorm(xs, g_final)

    return (y_prompt, y_sample,
            jnp.stack(pk), jnp.stack(pv), jnp.stack(pc), jnp.stack(pp), jnp.stack(pmk), jnp.stack(pmv),
            jnp.stack(sk), jnp.stack(sv), jnp.stack(sc), jnp.stack(sp))
```

```cpp
#include <hip/hip_runtime.h>
#include <hip/hip_cooperative_groups.h>
#include <cstdio>
#include <cstdint>
namespace cg = cooperative_groups;

#define LAS __attribute__((address_space(3)))
typedef unsigned short bf16_t;
typedef short bf16x8 __attribute__((ext_vector_type(8)));
typedef short s16x4 __attribute__((ext_vector_type(4)));
typedef float f32x4 __attribute__((ext_vector_type(4)));
typedef float f32x16 __attribute__((ext_vector_type(16)));
typedef unsigned u32x4 __attribute__((ext_vector_type(4)));
typedef unsigned u32x2 __attribute__((ext_vector_type(2)));

constexpr int D = 1024, SEQ = 8192, TP = 2 * SEQ, TS = 512, T = TP + TS, DFF = 2816, DIN = 2560, NL = 4;
constexpr int NW = 8;
constexpr float EPS = 1e-6f, LOG2E = 1.4426950408889634f;
constexpr size_t OFF_Y = 0;
constexpr size_t OFF_KP = (size_t)T * D;
constexpr size_t OFF_VP = OFF_KP + (size_t)NL * 2 * 512 * 512;
constexpr size_t OFF_CP = OFF_VP + (size_t)NL * 2 * 512 * 512;
constexpr size_t OFF_PP = OFF_CP + (size_t)NL * 2 * 2 * 256;
constexpr size_t OFF_MK = OFF_PP + (size_t)NL * 2 * 15 * 256;
constexpr size_t OFF_MV = OFF_MK + (size_t)NL * 512 * 1024;
constexpr size_t OFF_KS = OFF_MV + (size_t)NL * 512 * 1024;
constexpr size_t OFF_VS = OFF_KS + (size_t)NL * 32 * 512 * 512;
constexpr size_t OFF_CS = OFF_VS + (size_t)NL * 32 * 512 * 512;
constexpr size_t OFF_PS = OFF_CS + (size_t)NL * 32 * 2 * 256;
constexpr size_t OUT_TOTAL = OFF_PS + (size_t)NL * 32 * 15 * 256;
static_assert(OUT_TOTAL == 93390848, "output size");

constexpr size_t al(size_t x) { return (x + 1048575) & ~(size_t)1048575; }
constexpr size_t WS_X = 0;
constexpr size_t WS_XB = WS_X + al((size_t)T * D * 4);
constexpr size_t WS_SS = WS_XB + al((size_t)T * D * 2);
constexpr size_t WS_ACT = WS_SS + al((size_t)T * 16 * 4);
constexpr size_t WS_Z = WS_ACT + al((size_t)T * DFF * 2);
constexpr size_t WS_MIX = WS_Z + al((size_t)T * DIN * 2);
constexpr size_t WS_Q2 = WS_MIX + al((size_t)T * D * 2);
constexpr size_t WS_O2 = WS_Q2 + al((size_t)T * D * 2);
constexpr size_t WS_MEMB = WS_O2 + al((size_t)T * D * 2);
constexpr size_t WS_SSM = WS_MEMB + al((size_t)512 * D * 2);
constexpr size_t WS_MEMKV = WS_SSM + al((size_t)512 * 16 * 4);
constexpr size_t WS_W1 = WS_MEMKV + al((size_t)8 * 512 * D * 2);
constexpr size_t WS_WD = WS_W1 + al((size_t)8 * 2 * DFF * D * 2);
constexpr size_t WS_WIN = WS_WD + al((size_t)8 * D * DFF * 2);
constexpr size_t WS_WOUT = WS_WIN + al((size_t)NL * DIN * D * 2);
constexpr size_t WS_WXQ = WS_WOUT + al((size_t)NL * D * D * 2);
constexpr size_t WS_WXO = WS_WXQ + al((size_t)NL * D * D * 2);
constexpr size_t WS_WKV = WS_WXO + al((size_t)NL * D * D * 2);
constexpr size_t WS_PWT = WS_WKV + al((size_t)NL * 2 * D * D * 2);
constexpr size_t WS_HZC = WS_PWT + al((size_t)NL * 4 * 64 * 64 * 2);
constexpr size_t WS_HZP = WS_HZC + al((size_t)NL * 32 * 2 * 256 * 2);
constexpr size_t WS_KB16 = WS_HZP + al((size_t)NL * 32 * 15 * 256 * 2);
constexpr size_t WS_VB16 = WS_KB16 + al((size_t)NL * 32 * 512 * 512 * 2);
constexpr size_t WS_CTL = WS_VB16 + al((size_t)NL * 32 * 512 * 512 * 2);
constexpr size_t WS_END = WS_CTL + al(65536);

struct Params {
    const float* in[32];
    float* out;
    unsigned char* ws;
};

__device__ __forceinline__ unsigned cvt_pk_bf16(float lo, float hi) { unsigned r; asm("v_cvt_pk_bf16_f32 %0, %1, %2" : "=v"(r) : "v"(lo), "v"(hi)); return r; }
__device__ __forceinline__ float bf_lo(unsigned w) { return __uint_as_float(w << 16); }
__device__ __forceinline__ float bf_hi(unsigned w) { return __uint_as_float(w & 0xffff0000u); }
__device__ __forceinline__ void unpack8(bf16x8 v, float* f) {
    u32x4 w = __builtin_bit_cast(u32x4, v);
    f[0] = bf_lo(w.x); f[1] = bf_hi(w.x); f[2] = bf_lo(w.y); f[3] = bf_hi(w.y);
    f[4] = bf_lo(w.z); f[5] = bf_hi(w.z); f[6] = bf_lo(w.w); f[7] = bf_hi(w.w);
}
__device__ __forceinline__ bf16x8 pack8(const float* f) {
    u32x4 w; w.x = cvt_pk_bf16(f[0], f[1]); w.y = cvt_pk_bf16(f[2], f[3]); w.z = cvt_pk_bf16(f[4], f[5]); w.w = cvt_pk_bf16(f[6], f[7]);
    return __builtin_bit_cast(bf16x8, w);
}
__device__ __forceinline__ bf16x8 pack8v(f32x4 a, f32x4 b) {
    u32x4 w; w.x = cvt_pk_bf16(a[0], a[1]); w.y = cvt_pk_bf16(a[2], a[3]); w.z = cvt_pk_bf16(b[0], b[1]); w.w = cvt_pk_bf16(b[2], b[3]);
    return __builtin_bit_cast(bf16x8, w);
}
__device__ __forceinline__ float wave_sum(float v) {
#pragma unroll
    for (int o = 1; o < 64; o <<= 1) v += __shfl_xor(v, o);
    return v;
}
__device__ __forceinline__ float row_rstd(const float* SS, int row) {
    const f32x4* p = (const f32x4*)(SS + (size_t)row * 16);
    const f32x4 a = p[0], b = p[1], c = p[2], d = p[3];
    const float s = ((a[0] + a[1]) + (a[2] + a[3])) + ((b[0] + b[1]) + (b[2] + b[3])) + ((c[0] + c[1]) + (c[2] + c[3])) + ((d[0] + d[1]) + (d[2] + d[3]));
    return __builtin_amdgcn_rsqf(s * (1.0f / 1024.0f) + EPS);
}
__device__ __forceinline__ s16x4 tr_read(LAS unsigned char* p) {
    return __builtin_amdgcn_ds_read_tr16_b64_v4i16((LAS s16x4*)p);
}

namespace pg8 {
constexpr int BM = 256, BK = 64, HALF = 128, HTB = HALF * BK * 2, STAGE_BYTES = 8 * HTB, NXCD = 8, WGM = 8;
__host__ __device__ __forceinline__ int lds_byte(int r, int c) { const int st = (r >> 4) * 2 + (c >> 5), rr = r & 15, cc = c & 31, ob = rr * 64 + cc * 2; return st * 1024 + (ob ^ (((ob >> 9) & 1) << 5)); }
__host__ __device__ __forceinline__ void stage_rc(int b, int& R, int& C) { const int st = b / 1024, sb = b % 1024, swz = sb ^ (((sb >> 9) & 1) << 5); R = (st >> 1) * 16 + swz / 64; C = (st & 1) * 32 + (swz % 64) / 2; }
__host__ __device__ __forceinline__ int perm32(int rho) { const int n = rho >> 4, i = rho & 15; return 8 * (i >> 2) + 4 * n + (i & 3); }

struct Unit { int pm, pn; };
struct Gemm { const bf16_t* A; const bf16_t* Bt; int M, N, K; };

struct StaticOrder {
    int nM, nN, nwg, G, c;
    __device__ void init(int M, int N, int G_, int c_) { nM = M / BM; nN = N / BM; nwg = nM * nN; G = G_; c = c_; }
    __device__ bool next(int i, Unit& u) const {
        const long L = (long)i * G + c; if (L >= nwg) return false;
        int wgid = (int)L; { const int q = nwg / NXCD, r = nwg % NXCD, xcd = wgid % NXCD, off = wgid / NXCD; wgid = (xcd < r ? xcd * (q + 1) : r * (q + 1) + (xcd - r) * q) + off; }
        const int nig = WGM * nN, gid = wgid / nig, fm = gid * WGM, gsz = (nM - fm) < WGM ? (nM - fm) : WGM;
        u.pm = fm + ((wgid % nig) % gsz); u.pn = (wgid % nig) / gsz; return true;
    }
};

struct EpiSwiglu {
    bf16_t* O;
    __device__ __forceinline__ void operator()(const f32x4 (&acc)[2][2][4][2], const Unit& u, const LAS float* rsl, int wr, int wc, int fr, int fq) const {
        const int col0 = u.pn * 128 + wc * 32 + 8 * fq;
#pragma unroll
        for (int ai = 0; ai < 2; ++ai)
#pragma unroll
            for (int m = 0; m < 4; ++m) {
                const int rl = ai * HALF + wr * 64 + m * 16 + fr, row = u.pm * BM + rl;
                const float rs = rsl[rl];
                float o[8];
#pragma unroll
                for (int n = 0; n < 2; ++n)
#pragma unroll
                    for (int e = 0; e < 4; ++e) {
                        const float g = acc[ai][0][m][n][e] * rs, up = acc[ai][1][m][n][e] * rs;
                        const float sg = g * __builtin_amdgcn_rcpf(1.0f + __builtin_amdgcn_exp2f(-g * LOG2E));
                        o[n * 4 + e] = sg * up;
                    }
                *(bf16x8*)(O + (size_t)row * DFF + col0) = pack8(o);
            }
    }
};
struct EpiResid {
    float* X; bf16_t* XB; float* SS; float s;
    __device__ __forceinline__ void operator()(const f32x4 (&acc)[2][2][4][2], const Unit& u, const LAS float* rsl, int wr, int wc, int fr, int fq) const {
        bf16_t* base = XB + (size_t)(u.pm * BM + wr * 64 + fr) * D + u.pn * BM + wc * 32 + 8 * fq;
        bf16x8 xin[2][4][2];
#pragma unroll
        for (int ai = 0; ai < 2; ++ai)
#pragma unroll
            for (int m = 0; m < 4; ++m)
#pragma unroll
                for (int bj = 0; bj < 2; ++bj) xin[ai][m][bj] = *(const bf16x8*)(base + (size_t)(ai * HALF + m * 16) * D + bj * HALF);
#pragma unroll
        for (int ai = 0; ai < 2; ++ai)
#pragma unroll
            for (int m = 0; m < 4; ++m) {
                const int row = u.pm * BM + ai * HALF + wr * 64 + m * 16 + fr;
                float ss = 0.f;
#pragma unroll
                for (int bj = 0; bj < 2; ++bj) {
                    float xf[8]; unpack8(xin[ai][m][bj], xf);
                    f32x4 x0 = (f32x4){xf[0], xf[1], xf[2], xf[3]}, x1 = (f32x4){xf[4], xf[5], xf[6], xf[7]};
                    x0 += acc[ai][bj][m][0] * s; x1 += acc[ai][bj][m][1] * s;
                    *(bf16x8*)(base + (size_t)(ai * HALF + m * 16) * D + bj * HALF) = pack8v(x0, x1);
                    ss += (x0[0] * x0[0] + x0[1] * x0[1]) + (x0[2] * x0[2] + x0[3] * x0[3]) + (x1[0] * x1[0] + x1[1] * x1[1]) + (x1[2] * x1[2] + x1[3] * x1[3]);
                }
                ss += __shfl_xor(ss, 16); ss += __shfl_xor(ss, 32);
                if (fq == 0) SS[(size_t)row * 16 + u.pn * 4 + wc] = ss;
            }
    }
};
struct EpiScale {
    bf16_t* O; int ldc; float cs; int mode; float* out32;
    __device__ __forceinline__ void operator()(const f32x4 (&acc)[2][2][4][2], const Unit& u, const LAS float* rsl, int wr, int wc, int fr, int fq) const {
#pragma unroll
        for (int ai = 0; ai < 2; ++ai)
#pragma unroll
            for (int m = 0; m < 4; ++m) {
                const int rl = ai * HALF + wr * 64 + m * 16 + fr, row = u.pm * BM + rl;
                const float rs = rsl[rl] * cs;
#pragma unroll
                for (int bj = 0; bj < 2; ++bj) {
                    const int col = u.pn * BM + bj * HALF + wc * 32 + 8 * fq;
                    const f32x4 v0 = acc[ai][bj][m][0] * rs, v1 = acc[ai][bj][m][1] * rs;
                    if (mode == 0) {
                        *(bf16x8*)(O + (size_t)row * ldc + col) = pack8v(v0, v1);
                    } else {
                        const int t = col >> 10, c = col & 1023;
                        *(bf16x8*)(O + ((size_t)t * 512 + row) * 1024 + c) = pack8v(v0, v1);
                        float* o = out32 + (size_t)(t & 1) * (OFF_MV - OFF_MK) + (size_t)(t >> 1) * (512 * 1024) + (size_t)row * 1024 + c;
                        *(f32x4*)o = v0; *(f32x4*)(o + 4) = v1;
                    }
                }
            }
    }
};

template <class Epi>
__device__ __forceinline__ void gemm_phase(LAS unsigned char* lds, const Gemm g, const StaticOrder& S, const Epi& E, const float* SS) {
    int tid = threadIdx.x; asm volatile("" : "+v"(tid));
    LAS float* rsl = (LAS float*)(lds + STAGE_BYTES);
    const int wid = __builtin_amdgcn_readfirstlane(tid >> 6), lane = tid & 63, wr = wid >> 2, wc = wid & 3, fr = lane & 15, fq = lane >> 4;
    const int K = g.K, nt = K / BK;
    unsigned voffA[2], voffB[2];
#pragma unroll
    for (int i = 0; i < 2; ++i) { int R, C; stage_rc(tid * 16 + i * 8192, R, C); const int Rb = (R & ~31) + perm32(R & 31);
        voffA[i] = (unsigned)(R * K + C) * 2u; voffB[i] = (unsigned)(Rb * K + C) * 2u; }
    const size_t kstep = (size_t)(BK * 2);
    const size_t hstep = (size_t)HALF * K * 2;
    const size_t tstep = 2 * hstep;
    const unsigned ldsw = (unsigned)wid * 1024u;
    const int aoff = lds_byte(wr * 64 + fr, fq * 8), boff = lds_byte(wc * 32 + fr, fq * 8);
#define PG8_SA(b, h) (((b) * 2 + (h)) * HTB)
#define PG8_SB(b, h) ((4 + (b) * 2 + (h)) * HTB)
#define PG8_STAGE(bufoff, gbase, voff) do { _Pragma("unroll") for (int _i = 0; _i < 2; ++_i) \
        __builtin_amdgcn_global_load_lds((const unsigned*)((const char*)(gbase) + (voff)[_i]), (LAS unsigned*)(lds + (bufoff) + ldsw + _i * 8192), 16, 0, 0); } while (0)
#define PG8_LDA(dst, b, h) do { _Pragma("unroll") for (int m = 0; m < 4; ++m) _Pragma("unroll") for (int k = 0; k < 2; ++k) dst[m][k] = *(const LAS bf16x8*)(lds + PG8_SA(b, h) + aoff + m * 2048 + k * 1024); } while (0)
#define PG8_LDB(dst, b, h) do { _Pragma("unroll") for (int n = 0; n < 2; ++n) _Pragma("unroll") for (int k = 0; k < 2; ++k) dst[n][k] = *(const LAS bf16x8*)(lds + PG8_SB(b, h) + boff + n * 2048 + k * 1024); } while (0)
#define PG8_MMA(ai, bj, At, Bt) do { __builtin_amdgcn_s_setprio(1); _Pragma("unroll") for (int m = 0; m < 4; ++m) _Pragma("unroll") for (int n = 0; n < 2; ++n) _Pragma("unroll") for (int k = 0; k < 2; ++k) \
        acc[ai][bj][m][n] = __builtin_amdgcn_mfma_f32_16x16x32_bf16(Bt[n][k], At[m][k], acc[ai][bj][m][n], 0, 0, 0); __builtin_amdgcn_s_setprio(0); } while (0)
#define PG8_WAIT_V(n) asm volatile("s_waitcnt vmcnt(" #n ")" ::: "memory")
#define PG8_WAIT_L(n) asm volatile("s_waitcnt lgkmcnt(" #n ")" ::: "memory")
#define PG8_BAR __builtin_amdgcn_s_barrier()
#define PG8_SCHED __builtin_amdgcn_sched_barrier(0)
    Unit cur, nxt; int ui = 0;
    if (!S.next(0, cur)) return;
    f32x4 acc[2][2][4][2];
#pragma unroll
    for (int a = 0; a < 2; ++a)
#pragma unroll
        for (int b = 0; b < 2; ++b)
#pragma unroll
            for (int m = 0; m < 4; ++m)
#pragma unroll
                for (int n = 0; n < 2; ++n) acc[a][b][m][n] = (f32x4){0.f, 0.f, 0.f, 0.f};
    bf16x8 At[4][2], B0[2][2], B1[2][2];
    const char* cA = (const char*)g.A + (size_t)cur.pm * tstep; const char* cB = (const char*)g.Bt + (size_t)cur.pn * tstep;
    PG8_STAGE(PG8_SB(0, 0), cB, voffB); PG8_STAGE(PG8_SB(0, 1), cB + hstep, voffB); PG8_STAGE(PG8_SA(0, 0), cA, voffA); PG8_STAGE(PG8_SA(0, 1), cA + hstep, voffA);
    if (SS) {
        int pms[8];
#pragma unroll
        for (int i = 0; i < 8; ++i) { Unit uu; pms[i] = S.next(i, uu) ? uu.pm : -1; }
        if (tid < 256) {
            f32x4 v[8][4];
#pragma unroll
            for (int i = 0; i < 8; ++i) if (pms[i] >= 0) { const f32x4* p = (const f32x4*)(SS + (size_t)(pms[i] * BM + tid) * 16);
#pragma unroll
                for (int q = 0; q < 4; ++q) v[i][q] = p[q]; }
#pragma unroll
            for (int i = 0; i < 8; ++i) if (pms[i] >= 0) { float sm = 0.f;
#pragma unroll
                for (int q = 0; q < 4; ++q) sm += (v[i][q][0] + v[i][q][1]) + (v[i][q][2] + v[i][q][3]);
                rsl[i * 256 + tid] = __builtin_amdgcn_rsqf(sm * (1.0f / 1024.0f) + EPS); }
        }
        __syncthreads();
    }
    if (wr == 1) PG8_BAR;
    PG8_WAIT_V(2); PG8_BAR;
    PG8_STAGE(PG8_SB(1, 0), cB + kstep, voffB); PG8_STAGE(PG8_SA(1, 0), cA + kstep, voffA); PG8_STAGE(PG8_SB(1, 1), cB + hstep + kstep, voffB);
    PG8_WAIT_V(6); PG8_BAR;
    for (;;) {
        const bool has_next = S.next(ui + 1, nxt);
        const char* nA = has_next ? (const char*)g.A + (size_t)nxt.pm * tstep : cA; const char* nB = has_next ? (const char*)g.Bt + (size_t)nxt.pn * tstep : cB;
        for (int t = 0; t < nt; t += 2) {
            const bool last = (t == nt - 2);
            const char* a1 = cA + (size_t)(t + 1) * kstep;
            const char* a2 = last ? nA : cA + (size_t)(t + 2) * kstep; const char* b2 = last ? nB : cB + (size_t)(t + 2) * kstep;
            const char* a3 = a2 + kstep; const char* b3 = b2 + kstep;
            PG8_LDB(B0, 0, 0); PG8_LDB(B1, 0, 1); PG8_SCHED; PG8_LDA(At, 0, 0); PG8_STAGE(PG8_SA(1, 1), a1 + hstep, voffA);
            PG8_WAIT_V(8); PG8_WAIT_L(0); PG8_BAR; PG8_MMA(0, 0, At, B0); PG8_MMA(0, 1, At, B1); PG8_BAR; PG8_SCHED;
            PG8_LDA(At, 0, 1); PG8_STAGE(PG8_SB(0, 0), b2, voffB); PG8_STAGE(PG8_SB(0, 1), b2 + hstep, voffB); PG8_STAGE(PG8_SA(0, 0), a2, voffA);
            PG8_WAIT_V(8); PG8_WAIT_L(0); PG8_BAR; PG8_MMA(1, 0, At, B0); PG8_MMA(1, 1, At, B1); PG8_BAR; PG8_SCHED;
            PG8_LDB(B0, 1, 0); PG8_LDB(B1, 1, 1); PG8_SCHED; PG8_LDA(At, 1, 0); PG8_STAGE(PG8_SA(0, 1), a2 + hstep, voffA);
            PG8_WAIT_V(8); PG8_WAIT_L(0); PG8_BAR; PG8_MMA(0, 0, At, B0); PG8_MMA(0, 1, At, B1); PG8_BAR; PG8_SCHED;
            PG8_LDA(At, 1, 1); PG8_STAGE(PG8_SB(1, 0), b3, voffB); PG8_STAGE(PG8_SB(1, 1), b3 + hstep, voffB); PG8_STAGE(PG8_SA(1, 0), a3, voffA);
            PG8_WAIT_V(8); PG8_WAIT_L(0); PG8_BAR; PG8_MMA(1, 0, At, B0); PG8_MMA(1, 1, At, B1); PG8_BAR; PG8_SCHED;
        }
        if (wr == 0) PG8_BAR;
        E(acc, cur, rsl + ui * 256, wr, wc, fr, fq);
        if (!has_next) break;
#pragma unroll
        for (int a = 0; a < 2; ++a)
#pragma unroll
            for (int b = 0; b < 2; ++b)
#pragma unroll
                for (int m = 0; m < 4; ++m)
#pragma unroll
                    for (int n = 0; n < 2; ++n) acc[a][b][m][n] = (f32x4){0.f, 0.f, 0.f, 0.f};
        cur = nxt; cA = nA; cB = nB; ++ui;
        if (wr == 1) PG8_BAR;
    }
    PG8_WAIT_V(0);
    PG8_BAR;
#undef PG8_SA
#undef PG8_SB
#undef PG8_STAGE
#undef PG8_LDA
#undef PG8_LDB
#undef PG8_MMA
#undef PG8_WAIT_V
#undef PG8_WAIT_L
#undef PG8_BAR
#undef PG8_SCHED
}
}

template <int MODE>
__device__ __forceinline__ void small_gemm(LAS unsigned char* lds, const bf16_t* A, const bf16_t* Bt, int K, int unit, float* X, bf16_t* XB, float* SS, float sc, bf16_t* OUT) {
    int tid = threadIdx.x; asm volatile("" : "+v"(tid));
    const int wave = __builtin_amdgcn_readfirstlane(tid >> 6), lane = tid & 63, li = lane & 15, g4 = lane >> 4;
    const int rt = unit >> 3, ct = unit & 7, row0 = TP + 16 * rt, col0 = 128 * ct;
    const int KS = K >> 8;
    const int row = tid >> 5, c4 = (tid & 31) * 4;
    const size_t off = (size_t)(row0 + row) * D + col0 + c4;
    u32x2 xw; f32x4 sv[4];
    if (MODE == 0) xw = *(const u32x2*)(XB + off);
    else {
#pragma unroll
        for (int q = 0; q < 4; ++q) sv[q] = ((const f32x4*)(SS + (size_t)(row0 + row) * 16))[q]; }
    f32x4 acc[8];
#pragma unroll
    for (int t = 0; t < 8; ++t) acc[t] = (f32x4){0.f, 0.f, 0.f, 0.f};
    const bf16_t* ap = A + (size_t)(row0 + li) * K + 8 * g4 + 32 * wave * KS;
    const bf16_t* bp = Bt + (size_t)(col0 + li) * K + 8 * g4 + 32 * wave * KS;
#pragma unroll 4
    for (int ks = 0; ks < KS; ++ks) {
        const bf16x8 a = *(const bf16x8*)(ap + 32 * ks);
#pragma unroll
        for (int t = 0; t < 8; ++t) { const bf16x8 b = *(const bf16x8*)(bp + (size_t)16 * t * K + 32 * ks); acc[t] = __builtin_amdgcn_mfma_f32_16x16x32_bf16(b, a, acc[t], 0, 0, 0); }
    }
    LAS float* red = (LAS float*)lds;
#pragma unroll
    for (int t = 0; t < 8; ++t) *(LAS f32x4*)(red + (wave * 16 + li) * 128 + 16 * t + 4 * g4) = acc[t];
    __syncthreads();
    f32x4 sum = *(LAS f32x4*)(red + row * 128 + c4);
#pragma unroll
    for (int w = 1; w < 8; ++w) sum += *(LAS f32x4*)(red + (w * 16 + row) * 128 + c4);
    if (MODE == 0) {
        f32x4 x = (f32x4){bf_lo(xw.x), bf_hi(xw.x), bf_lo(xw.y), bf_hi(xw.y)}; x += sum * sc;
        u32x2 w; w.x = cvt_pk_bf16(x[0], x[1]); w.y = cvt_pk_bf16(x[2], x[3]); *(u32x2*)(XB + off) = w;
        float ss = (x[0] * x[0] + x[1] * x[1]) + (x[2] * x[2] + x[3] * x[3]);
        ss += __shfl_xor(ss, 1); ss += __shfl_xor(ss, 2); ss += __shfl_xor(ss, 4); ss += __shfl_xor(ss, 8); ss += __shfl_xor(ss, 16);
        if ((tid & 31) == 0) SS[(size_t)(row0 + row) * 16 + ct] = ss;
    } else {
        float sm = 0.f;
#pragma unroll
        for (int q = 0; q < 4; ++q) sm += (sv[q][0] + sv[q][1]) + (sv[q][2] + sv[q][3]);
        const float rs = __builtin_amdgcn_rsqf(sm * (1.0f / 1024.0f) + EPS) * sc;
        u32x2 w; w.x = cvt_pk_bf16(sum[0] * rs, sum[1] * rs); w.y = cvt_pk_bf16(sum[2] * rs, sum[3] * rs); *(u32x2*)(OUT + off) = w;
    }
    __syncthreads();
}

__device__ __forceinline__ void small_gemm_q256(LAS unsigned char* lds, const bf16_t* A, const bf16_t* Bt, int unit, const float* SS, float sc, bf16_t* OUT) {
    int tid = threadIdx.x; asm volatile("" : "+v"(tid));
    const int wave = __builtin_amdgcn_readfirstlane(tid >> 6), lane = tid & 63, li = lane & 15, g4 = lane >> 4;
    const int rt = unit >> 2, ct = unit & 3, row0 = TP + 16 * rt, col0 = 256 * ct;
    constexpr int K = D, KS = 4;
    const int row = tid >> 5;
    f32x4 sv[4];
#pragma unroll
    for (int q = 0; q < 4; ++q) sv[q] = ((const f32x4*)(SS + (size_t)(row0 + row) * 16))[q];
    f32x4 acc[16];
#pragma unroll
    for (int t = 0; t < 16; ++t) acc[t] = (f32x4){0.f, 0.f, 0.f, 0.f};
    const bf16_t* ap = A + (size_t)(row0 + li) * K + 8 * g4 + 32 * wave * KS;
    const bf16_t* bp = Bt + (size_t)(col0 + li) * K + 8 * g4 + 32 * wave * KS;
#pragma unroll 2
    for (int ks = 0; ks < KS; ++ks) {
        const bf16x8 a = *(const bf16x8*)(ap + 32 * ks);
#pragma unroll
        for (int t = 0; t < 16; ++t) { const bf16x8 b = *(const bf16x8*)(bp + (size_t)16 * t * K + 32 * ks); acc[t] = __builtin_amdgcn_mfma_f32_16x16x32_bf16(b, a, acc[t], 0, 0, 0); }
    }
    LAS float* red = (LAS float*)lds;
#pragma unroll
    for (int t = 0; t < 16; ++t) *(LAS f32x4*)(red + (wave * 16 + li) * 256 + 16 * t + 4 * g4) = acc[t];
    __syncthreads();
    float sm = 0.f;
#pragma unroll
    for (int q = 0; q < 4; ++q) sm += (sv[q][0] + sv[q][1]) + (sv[q][2] + sv[q][3]);
    const float rs = __builtin_amdgcn_rsqf(sm * (1.0f / 1024.0f) + EPS) * sc;
#pragma unroll
    for (int cc = 0; cc < 2; ++cc) {
        const int c4 = (tid & 31) * 4 + 128 * cc;
        f32x4 sum = *(LAS f32x4*)(red + row * 256 + c4);
#pragma unroll
        for (int w = 1; w < 8; ++w) sum += *(LAS f32x4*)(red + (w * 16 + row) * 256 + c4);
        u32x2 w; w.x = cvt_pk_bf16(sum[0] * rs, sum[1] * rs); w.y = cvt_pk_bf16(sum[2] * rs, sum[3] * rs);
        *(u32x2*)(OUT + (size_t)(row0 + row) * D + col0 + c4) = w;
    }
    asm volatile("s_waitcnt vmcnt(0)" ::: "memory");
    __syncthreads();
}

__device__ __forceinline__ void transpose_item(const float* W, int K, int N, const float* gain, bf16_t* WT, int dst_row0, LAS float* scr, int kb, int n0, int lane) {
    const int k0 = 64 * kb, n4 = (lane & 7) * 4, kr = lane >> 3;
    f32x4 v[8]; float g[8];
#pragma unroll
    for (int i = 0; i < 8; ++i) { v[i] = *(const f32x4*)(W + (size_t)(k0 + kr + 8 * i) * N + n0 + n4); g[i] = gain ? gain[k0 + kr + 8 * i] : 1.0f; }
#pragma unroll
    for (int i = 0; i < 8; ++i) { LAS float* d = scr + (kr + 8 * i) * 33 + n4; d[0] = v[i][0] * g[i]; d[1] = v[i][1] * g[i]; d[2] = v[i][2] * g[i]; d[3] = v[i][3] * g[i]; }
    asm volatile("s_waitcnt lgkmcnt(0)" ::: "memory");
    const int c = lane & 7;
#pragma unroll
    for (int j = 0; j < 4; ++j) { const int n = (lane >> 3) + 8 * j; const LAS float* s = scr + (8 * c) * 33 + n;
        u32x4 o; o.x = cvt_pk_bf16(s[0 * 33], s[1 * 33]); o.y = cvt_pk_bf16(s[2 * 33], s[3 * 33]); o.z = cvt_pk_bf16(s[4 * 33], s[5 * 33]); o.w = cvt_pk_bf16(s[6 * 33], s[7 * 33]);
        *(u32x4*)(WT + (size_t)(dst_row0 + n) * K + k0 + 8 * c) = o; }
    asm volatile("s_waitcnt lgkmcnt(0)" ::: "memory");
}

constexpr int WI_UP = 16 * 88, WI_DN = 44 * 32, WI_IN = 16 * 80, WI_SQ = 16 * 32;
constexpr int W_PER_L = 4 * WI_UP + 2 * WI_DN + WI_IN + 5 * WI_SQ, W_NOKV = W_PER_L - 2 * WI_SQ;
__device__ __forceinline__ void weight_item(const Params& P, unsigned char* ws, LAS float* scr, int l, int r, int lane) {
    constexpr int I_UP = WI_UP, I_DN = WI_DN, I_IN = WI_IN, I_SQ = WI_SQ;
        bf16_t* W1a = (bf16_t*)(ws + WS_W1) + (size_t)(2 * l) * 2 * DFF * D; bf16_t* W1b = W1a + (size_t)2 * DFF * D;
        bf16_t* WDa = (bf16_t*)(ws + WS_WD) + (size_t)(2 * l) * D * DFF; bf16_t* WDb = WDa + (size_t)D * DFF;
        const size_t oU = (size_t)l * D * DFF, oS = (size_t)l * D * D;
#define TR_UP(IDX, GIDX, WT, ISUP) { const int kb = r / 88, n0 = (r % 88) * 32; transpose_item(P.in[IDX] + oU, D, DFF, P.in[GIDX] + l * D, WT, (n0 >> 7) * 256 + (n0 & 127) + (ISUP) * 128, scr, kb, n0, lane); return; }
        if (r < I_UP) TR_UP(10, 9, W1a, 0)
        r -= I_UP;
        if (r < I_UP) TR_UP(11, 9, W1a, 1)
        r -= I_UP;
        if (r < I_UP) TR_UP(28, 27, W1b, 0)
        r -= I_UP;
        if (r < I_UP) TR_UP(29, 27, W1b, 1)
        r -= I_UP;
#undef TR_UP
        if (r < I_DN) { const int kb = r / 32, n0 = (r % 32) * 32; transpose_item(P.in[12] + oU, DFF, D, nullptr, WDa, n0, scr, kb, n0, lane); return; }
        r -= I_DN;
        if (r < I_DN) { const int kb = r / 32, n0 = (r % 32) * 32; transpose_item(P.in[30] + oU, DFF, D, nullptr, WDb, n0, scr, kb, n0, lane); return; }
        r -= I_DN;
        if (r < I_IN) { const int kb = r / 80, n0 = (r % 80) * 32; transpose_item(P.in[14] + (size_t)l * D * DIN, D, DIN, P.in[13] + l * D, (bf16_t*)(ws + WS_WIN) + (size_t)l * DIN * D, n0, scr, kb, n0, lane); return; }
        r -= I_IN;
        {
            const int q = r / I_SQ; r %= I_SQ; const int kb = r / 32, n0 = (r % 32) * 32;
            if (q == 0) transpose_item(P.in[20] + oS, D, D, P.in[19] + l * D, (bf16_t*)(ws + WS_WOUT) + oS, n0, scr, kb, n0, lane);
            else if (q == 1) transpose_item(P.in[23] + oS, D, D, P.in[21] + l * D, (bf16_t*)(ws + WS_WXQ) + oS, n0, scr, kb, n0, lane);
            else if (q == 2) transpose_item(P.in[26] + oS, D, D, nullptr, (bf16_t*)(ws + WS_WXO) + oS, n0, scr, kb, n0, lane);
            else if (q == 3) transpose_item(P.in[24] + oS, D, D, P.in[22] + l * D, (bf16_t*)(ws + WS_WKV), l * 2048 + n0, scr, kb, n0, lane);
            else transpose_item(P.in[25] + oS, D, D, P.in[22] + l * D, (bf16_t*)(ws + WS_WKV), l * 2048 + 1024 + n0, scr, kb, n0, lane);
        }
}
__device__ __forceinline__ void weights_deferred(const Params& P, LAS unsigned char* lds, int l, int part, int nparts) {
    int tid = threadIdx.x; asm volatile("" : "+v"(tid));
    const int lane = tid & 63, wave = __builtin_amdgcn_readfirstlane(tid >> 6);
    LAS float* scr = (LAS float*)(lds + wave * 16384);
    for (int r = part * NW + wave; r < W_NOKV; r += nparts * NW) weight_item(P, P.ws, scr, l, r, lane);
}

__device__ __forceinline__ void cache_convert(const Params& P, int l, int pct0, int pct1, int part, int nparts);
__device__ __forceinline__ void prologue(const Params& P, LAS unsigned char* lds, int G, int vcu) {
    int tid = threadIdx.x; asm volatile("" : "+v"(tid));
    const int lane = tid & 63, wave = __builtin_amdgcn_readfirstlane(tid >> 6);
    LAS float* scr = (LAS float*)(lds + wave * 16384);
    unsigned char* ws = P.ws;
    const int gw = vcu * NW + wave, NGW = G * NW;
    for (int it = gw; it < NL * W_PER_L; it += NGW) weight_item(P, ws, scr, it / W_PER_L, it % W_PER_L, lane);
    float* X = (float*)(ws + WS_X); bf16_t* XB = (bf16_t*)(ws + WS_XB); float* SS = (float*)(ws + WS_SS);
    for (int m = gw; m < T + 512; m += NGW) {
        const bool ismem = m >= T;
        const float* xp0 = P.in[0]; const float* xs0 = P.in[1]; const float* mp0 = P.in[2];
        const float* src = ismem ? mp0 + (size_t)(m - T) * D : (m < TP ? xp0 + (size_t)m * D : xs0 + (size_t)(m - TP) * D);
        f32x4 v[4]; float ss = 0.f;
#pragma unroll
        for (int j = 0; j < 4; ++j) { v[j] = ((const f32x4*)src)[lane + 64 * j]; ss += (v[j][0] * v[j][0] + v[j][1] * v[j][1]) + (v[j][2] * v[j][2] + v[j][3] * v[j][3]); }
        ss = wave_sum(ss);
        bf16_t* xb = ismem ? (bf16_t*)(ws + WS_MEMB) + (size_t)(m - T) * D : XB + (size_t)m * D;
        float* ssp = ismem ? (float*)(ws + WS_SSM) + (size_t)(m - T) * 16 : SS + (size_t)m * 16;
#pragma unroll
        for (int j = 0; j < 4; ++j) {
            u32x2 w; w.x = cvt_pk_bf16(v[j][0], v[j][1]); w.y = cvt_pk_bf16(v[j][2], v[j][3]);
            ((u32x2*)xb)[lane + 64 * j] = w;
        }
        if (lane < 16) ssp[lane] = lane == 0 ? ss : 0.f;
    }
    {
        bf16_t* HZC = (bf16_t*)(ws + WS_HZC); bf16_t* HZP = (bf16_t*)(ws + WS_HZP);
        for (int i = (vcu * NW + wave) * 64 + lane; i < NL * 32 * 2 * 256; i += NGW * 64) HZC[i] = (bf16_t)(cvt_pk_bf16(P.in[5][i], 0.f) & 0xffffu);
        for (int i = (vcu * NW + wave) * 64 + lane; i < NL * 32 * 15 * 256; i += NGW * 64) HZP[i] = (bf16_t)(cvt_pk_bf16(P.in[6][i], 0.f) & 0xffffu);
    }
    bf16_t* PWT = (bf16_t*)(ws + WS_PWT);
    for (int i = (vcu * NW + wave) * 64 + lane; i < NL * 4 * 64 * 64; i += NGW * 64) {
        const int c = i & 63, dout = (i >> 6) & 63, lg = i >> 12;
        const float v = P.in[17][((size_t)lg * 64 + c) * 64 + dout] * P.in[18][lg * 64 + dout];
        PWT[i] = (bf16_t)(cvt_pk_bf16(v, 0.f) & 0xffffu);
    }
}

__device__ __forceinline__ void cache_convert(const Params& P, int l, int pct0, int pct1, int part, int nparts) {
    int tid = threadIdx.x; asm volatile("" : "+v"(tid));
    constexpr unsigned NGL = 32u * 512u * 512u / 8u;
    const unsigned g0 = (unsigned)((unsigned long long)(2u * NGL) * pct0 / 100u), g1 = (unsigned)((unsigned long long)(2u * NGL) * pct1 / 100u);
    const float* ck = P.in[3] + (size_t)l * 32 * 512 * 512; const float* cv = P.in[4] + (size_t)l * 32 * 512 * 512;
    bf16_t* kb = (bf16_t*)(P.ws + WS_KB16) + (size_t)l * 32 * 512 * 512; bf16_t* vb = (bf16_t*)(P.ws + WS_VB16) + (size_t)l * 32 * 512 * 512;
    float* ok = P.out + OFF_KS + (size_t)l * 32 * 512 * 512; float* ov = P.out + OFF_VS + (size_t)l * 32 * 512 * 512;
#pragma unroll 8
    for (unsigned gi = g0 + (unsigned)part * 512u + tid; gi < g1; gi += (unsigned)nparts * 512u) {
        const bool isv = gi >= NGL; const unsigned e = (isv ? gi - NGL : gi) * 8u; const int key = (int)((e >> 9) & 511u);
        const float* src = (isv ? cv : ck) + e;
        const f32x4 k0 = *(const f32x4*)src, k1 = *(const f32x4*)(src + 4);
        *(bf16x8*)((isv ? vb : kb) + e) = pack8v(k0, k1);
        if (key >= 16) { float* d = (isv ? ov : ok) + e - 16 * 512; *(f32x4*)d = k0; *(f32x4*)(d + 4) = k1; }
    }
}

__device__ __forceinline__ int voff_band(int key, int d) { return ((key >> 3) * 2 + (d >> 5)) * 512 + (key & 7) * 64 + (d & 31) * 2; }
__device__ __forceinline__ void store8f(float* p, const float* f) { *(f32x4*)p = (f32x4){f[0], f[1], f[2], f[3]}; *(f32x4*)(p + 4) = (f32x4){f[4], f[5], f[6], f[7]}; }
__device__ __forceinline__ bf16x8 load8f_bf(const float* p) { const f32x4 a = *(const f32x4*)p, b = *(const f32x4*)(p + 4); return pack8v(a, b); }

struct AttnState { f32x16 O[2]; float mrun, lsum; };
__device__ __forceinline__ int koff_band(int row, int chunk) { return row * 128 + ((chunk ^ ((row >> 1) & 7)) << 4); }
__device__ __forceinline__ void attn_score(AttnState& st, bf16x8 (&pf)[2], const bf16x8 (&kf)[4], const bf16x8 (&qf)[4], int j, int qi, bool mask_hi, LAS float* tab, float tconst, int lane);
__device__ __forceinline__ void k_frags(bf16x8 (&kf)[4], const bf16x8 (&kraw)[4], LAS unsigned char* kst, int lane) {
    const int hi = lane >> 5, r = lane & 31;
#pragma unroll
    for (int i = 0; i < 4; ++i) *(LAS bf16x8*)(kst + koff_band((lane >> 3) + 8 * i, lane & 7)) = kraw[i];
#pragma unroll
    for (int d0 = 0; d0 < 4; ++d0) kf[d0] = *(const LAS bf16x8*)(kst + koff_band(r, 2 * d0 + hi));
}
__device__ __forceinline__ void attn_qk(AttnState& st, bf16x8 (&pf)[2], const bf16x8 (&kraw)[4], const bf16x8 (&qf)[4], int j, int qi, bool mask_hi,
                                        LAS float* tab, float tconst, LAS unsigned char* kst, int lane) {
    bf16x8 kf[4];
    k_frags(kf, kraw, kst, lane);
    attn_score(st, pf, kf, qf, j, qi, mask_hi, tab, tconst, lane);
}
__device__ __forceinline__ void attn_score(AttnState& st, bf16x8 (&pf)[2], const bf16x8 (&kf)[4], const bf16x8 (&qf)[4], int j, int qi, bool mask_hi,
                                           LAS float* tab, float tconst, int lane) {
    constexpr float C2 = 0.125f * LOG2E;
    const int hi = lane >> 5;
    f32x16 s;
#pragma unroll
    for (int e = 0; e < 16; ++e) s[e] = 0.f;
#pragma unroll
    for (int d0 = 0; d0 < 4; ++d0) s = __builtin_amdgcn_mfma_f32_32x32x16_bf16(kf[d0], qf[d0], s, 0, 0, 0);
    if (j >= 12) {
        const int base = 512 + qi - 32 * j - 4 * hi;
#pragma unroll
        for (int e = 0; e < 16; ++e) { int rel = base - ((e & 3) + 8 * (e >> 2)); rel = rel < 128 ? rel : 128; s[e] = s[e] * C2 + tab[rel + 128]; }
    } else {
#pragma unroll
        for (int e = 0; e < 16; ++e) s[e] = s[e] * C2 + tconst;
    }
    if (mask_hi) {
#pragma unroll
        for (int e = 8; e < 16; ++e) s[e] = -1e30f;
    }
    float mx = s[0];
#pragma unroll
    for (int e = 1; e < 16; ++e) mx = fmaxf(mx, s[e]);
    mx = fmaxf(mx, __shfl_xor(mx, 32));
    if (__any(mx > st.mrun + 8.0f)) {
        const float mnew = fmaxf(st.mrun, mx);
        const float alpha = __builtin_amdgcn_exp2f(st.mrun - mnew);
        st.mrun = mnew; st.lsum *= alpha;
#pragma unroll
        for (int db = 0; db < 2; ++db)
#pragma unroll
            for (int e = 0; e < 16; ++e) st.O[db][e] *= alpha;
    }
    float ps = 0.f;
#pragma unroll
    for (int e = 0; e < 16; ++e) { s[e] = __builtin_amdgcn_exp2f(s[e] - st.mrun); ps += s[e]; }
    st.lsum += ps;
#pragma unroll
    for (int s2 = 0; s2 < 2; ++s2) { u32x4 w; w.x = cvt_pk_bf16(s[8 * s2 + 0], s[8 * s2 + 1]); w.y = cvt_pk_bf16(s[8 * s2 + 2], s[8 * s2 + 3]); w.z = cvt_pk_bf16(s[8 * s2 + 4], s[8 * s2 + 5]); w.w = cvt_pk_bf16(s[8 * s2 + 6], s[8 * s2 + 7]);
        pf[s2] = __builtin_bit_cast(bf16x8, w); }
}
__device__ __forceinline__ void attn_pv(AttnState& st, const bf16x8 (&pf)[2], const bf16x8 (&vv)[4], LAS unsigned char* vst, int lane) {
    const int hi = lane >> 5;
#pragma unroll
    for (int i = 0; i < 4; ++i) { const int vr = (lane >> 3) + 8 * i, ch = lane & 7; *(LAS bf16x8*)(vst + voff_band(vr, 8 * ch)) = vv[i]; }
    const int trow = 4 * hi + ((lane & 15) >> 2), tcol = 16 * ((lane >> 4) & 1) + 4 * (lane & 3);
#pragma unroll
    for (int db = 0; db < 2; ++db)
#pragma unroll
        for (int s2 = 0; s2 < 2; ++s2) {
            const s16x4 a0 = tr_read(vst + voff_band(16 * s2 + trow, 32 * db + tcol));
            const s16x4 a1 = tr_read(vst + voff_band(16 * s2 + 8 + trow, 32 * db + tcol));
            const bf16x8 vf = (bf16x8){a0[0], a0[1], a0[2], a0[3], a1[0], a1[1], a1[2], a1[3]};
            st.O[db] = __builtin_amdgcn_mfma_f32_32x32x16_bf16(vf, pf[s2], st.O[db], 0, 0, 0);
        }
}

template <bool SAMPLE>
__device__ __forceinline__ void band_attn(const Params& P, int l, int b, int c, int h, int qb0, int jlo, int jhi, LAS unsigned char* wl, int lane_) {
    int lane = lane_; asm volatile("" : "+v"(lane));
    const int r = lane & 31, hi = lane >> 5;
    LAS float* tab = (LAS float*)wl;
    LAS unsigned char* vst = wl + 2048;
    LAS unsigned char* kst = wl + 6144;
    const bf16_t* Z = (const bf16_t*)(P.ws + WS_Z);
    bf16_t* MIX = (bf16_t*)(P.ws + WS_MIX);
    const float* rb = P.in[15] + (size_t)(l * 8 + h) * 257;
    for (int i = lane; i < 257; i += 64) tab[i] = rb[i] * LOG2E;
    const int qrow0 = SAMPLE ? (TP + b * 16) : (b * SEQ + c * 64);
    const int qi = SAMPLE ? (r & 15) : (32 * qb0 + r);
    bf16x8 qf[4];
#pragma unroll
    for (int d0 = 0; d0 < 4; ++d0) qf[d0] = *(const bf16x8*)(Z + (size_t)(qrow0 + qi) * DIN + h * 64 + 16 * d0 + 8 * hi);
    AttnState st; st.mrun = -1e30f; st.lsum = 0.f;
#pragma unroll
    for (int db = 0; db < 2; ++db)
#pragma unroll
        for (int e = 0; e < 16; ++e) st.O[db][e] = 0.f;
    const float tconst = tab[256];
    const int vr0 = lane >> 3, vch = lane & 7;
    const int NB = jhi;
    const int jb0 = SAMPLE ? jlo : (c < 8 ? (8 - c) * 2 : 0);
    const int krow0 = b * SEQ + (c - 8) * 64;
    const size_t cb = (size_t)(l * 32 + b) * 512;
    const bf16_t* KB = (const bf16_t*)(P.ws + WS_KB16); const bf16_t* VB = (const bf16_t*)(P.ws + WS_VB16);
#define KPTR(j, i) (SAMPLE ? ((j) < 16 ? KB + ((cb + 32 * (j) + vr0 + 8 * (i)) * 8 + h) * 64 + 8 * vch : Z + (size_t)(qrow0 + ((vr0 + 8 * (i)) & 15)) * DIN + 512 + h * 64 + 8 * vch) \
                           : Z + (size_t)(krow0 + 32 * (j) + vr0 + 8 * (i)) * DIN + 512 + h * 64 + 8 * vch)
#define VPTR(j, i) (SAMPLE ? ((j) < 16 ? VB + ((cb + 32 * (j) + vr0 + 8 * (i)) * 8 + h) * 64 + 8 * vch : Z + (size_t)(qrow0 + ((vr0 + 8 * (i)) & 15)) * DIN + 1024 + h * 64 + 8 * vch) \
                           : Z + (size_t)(krow0 + 32 * (j) + vr0 + 8 * (i)) * DIN + 1024 + h * 64 + 8 * vch)
    bf16x8 kc[4], kn[4], kn2[4], vc[4], vn[4];
    {
#pragma unroll
      for (int i = 0; i < 4; ++i) kc[i] = *(const bf16x8*)(KPTR(jb0, i));
#pragma unroll
      for (int i = 0; i < 4; ++i) vc[i] = *(const bf16x8*)(VPTR(jb0, i));
#pragma unroll
      for (int i = 0; i < 4; ++i) kn[i] = *(const bf16x8*)(KPTR(jb0 + 1, i)); }
    for (int j = jb0; j < NB; ++j) {
        if (j + 2 < NB) {
#pragma unroll
            for (int i = 0; i < 4; ++i) kn2[i] = *(const bf16x8*)(KPTR(j + 2, i)); }
        if (j + 1 < NB) {
#pragma unroll
            for (int i = 0; i < 4; ++i) vn[i] = *(const bf16x8*)(VPTR(j + 1, i)); }
        bf16x8 pf[2];
        attn_qk(st, pf, kc, qf, j, qi, SAMPLE && j == 16, tab, tconst, kst, lane);
        if (!SAMPLE) {
            if (c >= 120 && j >= 16 && qb0 == 0) {
                const size_t ob = (size_t)((l * 2 + b) * 512 + (c - 120) * 64 + 32 * (j - 16));
#pragma unroll
                for (int i = 0; i < 4; ++i) { float f[8]; unpack8(vc[i], f); store8f(P.out + OFF_VP + ((ob + vr0 + 8 * i) * 8 + h) * 64 + 8 * vch, f); }
#pragma unroll
                for (int i = 0; i < 4; ++i) { float f[8]; unpack8(kc[i], f); store8f(P.out + OFF_KP + ((ob + vr0 + 8 * i) * 8 + h) * 64 + 8 * vch, f); }
            }
        } else {
            if (j == 16) {
#pragma unroll
                for (int i = 0; i < 2; ++i) { float f[8]; unpack8(kc[i], f); store8f(P.out + OFF_KS + ((cb + 496 + vr0 + 8 * i) * 8 + h) * 64 + 8 * vch, f);
                    unpack8(vc[i], f); store8f(P.out + OFF_VS + ((cb + 496 + vr0 + 8 * i) * 8 + h) * 64 + 8 * vch, f); }
            }
        }
        attn_pv(st, pf, vc, vst, lane);
#pragma unroll
        for (int d0 = 0; d0 < 4; ++d0) { kc[d0] = kn[d0]; kn[d0] = kn2[d0]; vc[d0] = vn[d0]; }
    }
#undef KPTR
#undef VPTR
    float ls = st.lsum; ls += __shfl_xor(ls, 32);
    if (SAMPLE) {
        LAS float* op = (LAS float*)(wl + 10240); LAS float* ml = (LAS float*)(wl + 14336);
        if (r < 16) {
#pragma unroll
            for (int db = 0; db < 2; ++db)
#pragma unroll
                for (int e = 0; e < 16; ++e) op[(32 * db + (e & 3) + 8 * (e >> 2) + 4 * hi) * 16 + r] = st.O[db][e];
            if (hi == 0) { ml[2 * r] = st.mrun; ml[2 * r + 1] = ls; }
        }
        return;
    }
    const float inv = 1.0f / ls;
    float ssq = 0.f;
#pragma unroll
    for (int db = 0; db < 2; ++db)
#pragma unroll
        for (int e = 0; e < 16; ++e) { st.O[db][e] *= inv; ssq += st.O[db][e] * st.O[db][e]; }
    ssq += __shfl_xor(ssq, 32);
    const float rn = __builtin_amdgcn_rsqf(ssq * (1.0f / 64.0f) + EPS);
    if (!SAMPLE || r < 16) {
        bf16_t* op = MIX + (size_t)(qrow0 + qi) * D + h * 64 + 4 * hi;
#pragma unroll
        for (int db = 0; db < 2; ++db)
#pragma unroll
            for (int g4 = 0; g4 < 4; ++g4) { u32x2 w; w.x = cvt_pk_bf16(st.O[db][4 * g4] * rn, st.O[db][4 * g4 + 1] * rn); w.y = cvt_pk_bf16(st.O[db][4 * g4 + 2] * rn, st.O[db][4 * g4 + 3] * rn);
                *(u32x2*)(op + 32 * db + 8 * g4) = w; }
    }
}

__device__ __forceinline__ void band_attn_p2(const Params& P, int l, int b, int c, int h, LAS unsigned char* wl, int lane_) {
    int lane = lane_; asm volatile("" : "+v"(lane));
    const int r = lane & 31, hi = lane >> 5;
    LAS float* tab = (LAS float*)wl;
    LAS unsigned char* vst = wl + 2048;
    LAS unsigned char* kst = wl + 6144;
    const bf16_t* Z = (const bf16_t*)(P.ws + WS_Z);
    bf16_t* MIX = (bf16_t*)(P.ws + WS_MIX);
    const float* rb = P.in[15] + (size_t)(l * 8 + h) * 257;
    for (int i = lane; i < 257; i += 64) tab[i] = rb[i] * LOG2E;
    const int qrow0 = b * SEQ + c * 64;
    bf16x8 qf[2][4];
    AttnState st[2];
#pragma unroll
    for (int qb = 0; qb < 2; ++qb) {
#pragma unroll
        for (int d0 = 0; d0 < 4; ++d0) qf[qb][d0] = *(const bf16x8*)(Z + (size_t)(qrow0 + 32 * qb + r) * DIN + h * 64 + 16 * d0 + 8 * hi);
        st[qb].mrun = -1e30f; st[qb].lsum = 0.f;
#pragma unroll
        for (int db = 0; db < 2; ++db)
#pragma unroll
            for (int e = 0; e < 16; ++e) st[qb].O[db][e] = 0.f;
    }
    const float tconst = tab[256];
    const int vr0 = lane >> 3, vch = lane & 7;
    const int jb0 = c < 8 ? (8 - c) * 2 : 0;
    const bf16_t* zb = Z + (size_t)(b * SEQ + (c - 8) * 64 + vr0) * DIN + h * 64 + 8 * vch;
    bf16x8 kc[4], kn[4], vc[4];
#pragma unroll
    for (int i = 0; i < 4; ++i) kc[i] = *(const bf16x8*)(zb + (size_t)(32 * jb0 + 8 * i) * DIN + 512);
    for (int j = jb0; j < 18; ++j) {
#pragma unroll
        for (int i = 0; i < 4; ++i) vc[i] = *(const bf16x8*)(zb + (size_t)(32 * j + 8 * i) * DIN + 1024);
        if (j + 1 < 18) {
#pragma unroll
            for (int i = 0; i < 4; ++i) kn[i] = *(const bf16x8*)(zb + (size_t)(32 * (j + 1) + 8 * i) * DIN + 512);
        }
        bf16x8 kf[4], pf[2][2];
        k_frags(kf, kc, kst, lane);
#pragma unroll
        for (int qb = 0; qb < 2; ++qb) attn_score(st[qb], pf[qb], kf, qf[qb], j, 32 * qb + r, false, tab, tconst, lane);
#pragma unroll
        for (int i = 0; i < 4; ++i) *(LAS bf16x8*)(vst + voff_band(vr0 + 8 * i, 8 * vch)) = vc[i];
        const int trow = 4 * hi + ((lane & 15) >> 2), tcol = 16 * ((lane >> 4) & 1) + 4 * (lane & 3);
#pragma unroll
        for (int db = 0; db < 2; ++db)
#pragma unroll
            for (int s2 = 0; s2 < 2; ++s2) {
                const s16x4 a0 = tr_read(vst + voff_band(16 * s2 + trow, 32 * db + tcol));
                const s16x4 a1 = tr_read(vst + voff_band(16 * s2 + 8 + trow, 32 * db + tcol));
                const bf16x8 vf = (bf16x8){a0[0], a0[1], a0[2], a0[3], a1[0], a1[1], a1[2], a1[3]};
#pragma unroll
                for (int qb = 0; qb < 2; ++qb) st[qb].O[db] = __builtin_amdgcn_mfma_f32_32x32x16_bf16(vf, pf[qb][s2], st[qb].O[db], 0, 0, 0);
            }
#pragma unroll
        for (int i = 0; i < 4; ++i) kc[i] = kn[i];
    }
    if (c >= 120) {
        const size_t ob = (size_t)((l * 2 + b) * 512 + (c - 120) * 64);
        for (int i = 0; i < 8; ++i) { const int row = vr0 + 8 * i; float f[8];
            unpack8(*(const bf16x8*)(Z + (size_t)(qrow0 + row) * DIN + 512 + h * 64 + 8 * vch), f); store8f(P.out + OFF_KP + ((ob + row) * 8 + h) * 64 + 8 * vch, f);
            unpack8(*(const bf16x8*)(Z + (size_t)(qrow0 + row) * DIN + 1024 + h * 64 + 8 * vch), f); store8f(P.out + OFF_VP + ((ob + row) * 8 + h) * 64 + 8 * vch, f); }
    }
#pragma unroll
    for (int qb = 0; qb < 2; ++qb) {
        float ls = st[qb].lsum; ls += __shfl_xor(ls, 32);
        const float inv = 1.0f / ls;
        float ssq = 0.f;
#pragma unroll
        for (int db = 0; db < 2; ++db)
#pragma unroll
            for (int e = 0; e < 16; ++e) { st[qb].O[db][e] *= inv; ssq += st[qb].O[db][e] * st[qb].O[db][e]; }
        ssq += __shfl_xor(ssq, 32);
        const float rn = __builtin_amdgcn_rsqf(ssq * (1.0f / 64.0f) + EPS);
        bf16_t* op = MIX + (size_t)(qrow0 + 32 * qb + r) * D + h * 64 + 4 * hi;
#pragma unroll
        for (int db = 0; db < 2; ++db)
#pragma unroll
            for (int g4 = 0; g4 < 4; ++g4) { u32x2 w; w.x = cvt_pk_bf16(st[qb].O[db][4 * g4] * rn, st[qb].O[db][4 * g4 + 1] * rn); w.y = cvt_pk_bf16(st[qb].O[db][4 * g4 + 2] * rn, st[qb].O[db][4 * g4 + 3] * rn);
                *(u32x2*)(op + 32 * db + 8 * g4) = w; }
    }
}

__device__ __forceinline__ void sample_merge(const Params& P, int b, int h, LAS unsigned char* lds, int lane_) {
    int lane = lane_; asm volatile("" : "+v"(lane));
    bf16_t* MIX = (bf16_t*)(P.ws + WS_MIX);
    const int q = lane & 15, dq = lane >> 4;
    float mw[8], M = -1e30f;
#pragma unroll
    for (int w = 0; w < 8; ++w) { mw[w] = ((const LAS float*)(lds + w * 16384 + 14336))[2 * q]; M = fmaxf(M, mw[w]); }
    float L = 0.f, o[16];
#pragma unroll
    for (int e = 0; e < 16; ++e) o[e] = 0.f;
#pragma unroll
    for (int w = 0; w < 8; ++w) { const float sc = __builtin_amdgcn_exp2f(mw[w] - M); L += ((const LAS float*)(lds + w * 16384 + 14336))[2 * q + 1] * sc;
        const LAS float* op = (const LAS float*)(lds + w * 16384 + 10240);
#pragma unroll
        for (int e = 0; e < 16; ++e) o[e] += op[(16 * dq + e) * 16 + q] * sc; }
    const float inv = 1.0f / L; float ssq = 0.f;
#pragma unroll
    for (int e = 0; e < 16; ++e) { o[e] *= inv; ssq += o[e] * o[e]; }
    ssq += __shfl_xor(ssq, 16); ssq += __shfl_xor(ssq, 32);
    const float rn = __builtin_amdgcn_rsqf(ssq * (1.0f / 64.0f) + EPS);
#pragma unroll
    for (int e = 0; e < 16; ++e) o[e] *= rn;
    bf16_t* dst = MIX + (size_t)(TP + b * 16 + q) * D + h * 64 + 16 * dq;
    *(bf16x8*)dst = pack8(o); *(bf16x8*)(dst + 8) = pack8(o + 8);
}

template <bool SAMPLE>
__device__ __forceinline__ void conv_part(const Params& P, int l, int b, int c, int tid2_, int it_begin, int it_end, int nthr) {
    int tid2 = tid2_; asm volatile("" : "+v"(tid2));
    const bf16_t* Z = (const bf16_t*)(P.ws + WS_Z);
    bf16_t* MIX = (bf16_t*)(P.ws + WS_MIX);
    const bf16_t* HZC = (const bf16_t*)(P.ws + WS_HZC) + (size_t)(l * 32 + b) * 2 * 256;
    const int row0 = SAMPLE ? (TP + b * 16) : (b * SEQ + c * 64);
    const float* cw = P.in[16] + (size_t)l * 3 * 256;
#pragma unroll 2
    for (int it = it_begin + tid2; it < it_end; it += nthr) {
        const int o = it & 31, i = it >> 5, ch = 8 * o;
        const int tpos = SAMPLE ? i : (c * 64 + i);
        const bf16_t* zr = Z + (size_t)(row0 + i) * DIN;
        float bg[8], u[3][8];
        unpack8(*(const bf16x8*)(zr + 1536 + ch), bg);
#pragma unroll
        for (int k = 0; k < 3; ++k) {
            const bool ok = tpos - k >= 0;
            const bf16_t* zp = zr - (size_t)(ok ? k : 0) * DIN;
            float cg[8], hc[8]; unpack8(*(const bf16x8*)(zp + 1792 + ch), cg); unpack8(*(const bf16x8*)(zp + 2048 + ch), hc);
            float hz[8];
            if (SAMPLE) unpack8(*(const bf16x8*)(HZC + (ok ? 0 : (2 + tpos - k)) * 256 + ch), hz);
#pragma unroll
            for (int e = 0; e < 8; ++e) u[2 - k][e] = ok ? cg[e] * hc[e] : (SAMPLE ? hz[e] : 0.f);
        }
        float y[8], ssq = 0.f;
#pragma unroll
        for (int e = 0; e < 8; ++e) { y[e] = bg[e] * (cw[ch + e] * u[0][e] + cw[256 + ch + e] * u[1][e] + cw[512 + ch + e] * u[2][e]); ssq += y[e] * y[e]; }
        ssq += __shfl_xor(ssq, 1); ssq += __shfl_xor(ssq, 2); ssq += __shfl_xor(ssq, 4);
        const float rn = __builtin_amdgcn_rsqf(ssq * (1.0f / 64.0f) + EPS);
#pragma unroll
        for (int e = 0; e < 8; ++e) y[e] *= rn;
        *(bf16x8*)(MIX + (size_t)(row0 + i) * D + 512 + ch) = pack8(y);
        if (SAMPLE) { if (i >= 14) store8f(P.out + OFF_CS + ((size_t)(l * 32 + b) * 2 + (i - 14)) * 256 + ch, u[2]); }
        else { if (tpos >= SEQ - 2) store8f(P.out + OFF_CP + ((size_t)(l * 2 + b) * 2 + (tpos - (SEQ - 2))) * 256 + ch, u[2]); }
    }
}

template <bool SAMPLE, int GG>
__device__ __forceinline__ void pool_task(const Params& P, int l, int b, int c, int tb, int lane_) {
    int lane = lane_; asm volatile("" : "+v"(lane));
    constexpr int W = 2 << GG;
    const bf16_t* Z = (const bf16_t*)(P.ws + WS_Z);
    bf16_t* MIX = (bf16_t*)(P.ws + WS_MIX);
    const bf16_t* PW = (const bf16_t*)(P.ws + WS_PWT) + (size_t)(l * 4 + GG) * 4096;
    const bf16_t* HZP = (const bf16_t*)(P.ws + WS_HZP) + (size_t)(l * 32 + b) * 15 * 256 + GG * 64;
    const int r = lane & 31, hi = lane >> 5;
    const int row0 = SAMPLE ? (TP + b * 16) : (b * SEQ + c * 64);
    const int i = SAMPLE ? (r & 15) : (32 * tb + r);
    const int tpos = SAMPLE ? i : (c * 64 + i);
    const bf16_t* zr = Z + (size_t)(row0 + i) * DIN + 2304 + GG * 64 + 8 * hi;
    const float rc = 1.0f / (float)(SAMPLE ? W : (tpos + 1 < W ? tpos + 1 : W));
    bf16x8 pf[4];
#pragma unroll
    for (int ks = 0; ks < 4; ++ks) {
        bf16x8 v[W];
#pragma unroll
        for (int k = 0; k < W; ++k) {
            const int tp = tpos - k;
            const bf16_t* p = (tp >= 0) ? (zr - (size_t)k * DIN) : (SAMPLE ? (HZP + (15 + tp) * 256 + 8 * hi) : zr);
            v[k] = *(const bf16x8*)(p + 16 * ks);
        }
        float acc[8], cur[8];
        unpack8(v[0], cur);
#pragma unroll
        for (int e = 0; e < 8; ++e) acc[e] = cur[e];
#pragma unroll
        for (int k = 1; k < W; ++k) { float f[8]; unpack8(v[k], f); const bool use = SAMPLE || (tpos - k >= 0);
#pragma unroll
            for (int e = 0; e < 8; ++e) acc[e] += use ? f[e] : 0.f; }
#pragma unroll
        for (int e = 0; e < 8; ++e) acc[e] = acc[e] * rc - cur[e];
        pf[ks] = pack8(acc);
        if (SAMPLE) { if (r < 16 && i >= 1) store8f(P.out + OFF_PS + ((size_t)(l * 32 + b) * 15 + (i - 1)) * 256 + GG * 64 + 16 * ks + 8 * hi, cur); }
        else { if (tpos >= SEQ - 15) store8f(P.out + OFF_PP + ((size_t)(l * 2 + b) * 15 + (tpos - (SEQ - 15))) * 256 + GG * 64 + 16 * ks + 8 * hi, cur); }
    }
    f32x16 cc[2];
#pragma unroll
    for (int db = 0; db < 2; ++db) {
#pragma unroll
        for (int e = 0; e < 16; ++e) cc[db][e] = 0.f;
#pragma unroll
        for (int ks = 0; ks < 4; ++ks) { const bf16x8 a = *(const bf16x8*)(PW + (size_t)(32 * db + r) * 64 + 16 * ks + 8 * hi); cc[db] = __builtin_amdgcn_mfma_f32_32x32x16_bf16(a, pf[ks], cc[db], 0, 0, 0); }
    }
    float ssq = 0.f;
#pragma unroll
    for (int db = 0; db < 2; ++db)
#pragma unroll
        for (int e = 0; e < 16; ++e) ssq += cc[db][e] * cc[db][e];
    ssq += __shfl_xor(ssq, 32);
    const float rn = __builtin_amdgcn_rsqf(ssq * (1.0f / 64.0f) + EPS);
    if (!SAMPLE || r < 16) {
        bf16_t* op = MIX + (size_t)(row0 + i) * D + 768 + GG * 64 + 4 * hi;
#pragma unroll
        for (int db = 0; db < 2; ++db)
#pragma unroll
            for (int g4 = 0; g4 < 4; ++g4) { u32x2 wv; wv.x = cvt_pk_bf16(cc[db][4 * g4] * rn, cc[db][4 * g4 + 1] * rn); wv.y = cvt_pk_bf16(cc[db][4 * g4 + 2] * rn, cc[db][4 * g4 + 3] * rn);
                *(u32x2*)(op + 32 * db + 8 * g4) = wv; }
    }
}

__device__ __forceinline__ void mixer_phase(const Params& P, int l, LAS unsigned char* lds, int G, int vcu) {
    int tid = threadIdx.x; asm volatile("" : "+v"(tid));
    const int lane = tid & 63, wave = __builtin_amdgcn_readfirstlane(tid >> 6);
    LAS unsigned char* wl = lds + wave * 16384;
    for (int u = vcu; u < 256; u += G) {
        const int b = u >> 7, c = u & 127;
        band_attn_p2(P, l, b, c, wave, wl, lane);
        const int sb = u >> 3, sh = u & 7;
        band_attn<true>(P, l, sb, 0, sh, 0, 2 * wave, wave == 7 ? 17 : 2 * wave + 2, wl, lane);
        if (wave == 0) pool_task<false, 3>(P, l, b, c, 0, lane);
        else if (wave == 1) pool_task<false, 3>(P, l, b, c, 1, lane);
        else if (wave == 2) pool_task<false, 2>(P, l, b, c, 0, lane);
        else if (wave == 3) pool_task<false, 2>(P, l, b, c, 1, lane);
        else if (wave == 4) pool_task<false, 1>(P, l, b, c, 0, lane);
        else if (wave == 5) pool_task<false, 1>(P, l, b, c, 1, lane);
        else if (wave == 6) pool_task<false, 0>(P, l, b, c, 0, lane);
        else pool_task<false, 0>(P, l, b, c, 1, lane);
        { int t2 = threadIdx.x; asm volatile("" : "+v"(t2)); conv_part<false>(P, l, b, c, t2, 0, 2048, 512); }
        __syncthreads();
        if (wave == 0) sample_merge(P, sb, sh, lds, lane);
        else if (wave == 1) { if (sh == 0) pool_task<true, 0>(P, l, sb, 0, 0, lane); else if (sh == 1) pool_task<true, 1>(P, l, sb, 0, 0, lane);
                              else if (sh == 2) pool_task<true, 2>(P, l, sb, 0, 0, lane); else if (sh == 3) pool_task<true, 3>(P, l, sb, 0, 0, lane); }
        else if (wave < 4) { if (sh >= 4) { int t2 = threadIdx.x; asm volatile("" : "+v"(t2)); conv_part<true>(P, l, sb, 0, t2 - 128, (sh - 4) * 128, (sh - 4) * 128 + 128, 128); } }
        __syncthreads();
    }
}

__device__ __forceinline__ int voff_x(int key, int d) { return ((key >> 3) * 8 + (d >> 5)) * 512 + (key & 7) * 64 + (d & 31) * 2; }
__device__ __forceinline__ int koff_x(int mem, int chunk) { return mem * 512 + ((chunk ^ (mem & 15)) << 4); }

__device__ __forceinline__ void xattn_prompt_unit(const Params& P, int l, int qt, int h, LAS unsigned char* lds, int tid_) {
    int tid = tid_; asm volatile("" : "+v"(tid));
    const int lane = tid & 63, wave = __builtin_amdgcn_readfirstlane(tid >> 6), r = lane & 31, hi = lane >> 5;
    const int b = qt >> 5;
    const bf16_t* Q2 = (const bf16_t*)(P.ws + WS_Q2);
    bf16_t* O2 = (bf16_t*)(P.ws + WS_O2);
    const bf16_t* MK = (const bf16_t*)(P.ws + WS_MEMKV) + ((size_t)(2 * l) * 512 + b * 256) * 1024 + h * 256;
    const bf16_t* MV = (const bf16_t*)(P.ws + WS_MEMKV) + ((size_t)(2 * l + 1) * 512 + b * 256) * 1024 + h * 256;
    const int qrow = qt * 256 + wave * 32 + r;
    const int sm0 = tid >> 5, sc0 = tid & 31;
    const unsigned gsrc = (unsigned)(sm0 * 1024 + sc0 * 8);
    bf16x8 stg[2];
    stg[0] = *(const bf16x8*)(MK + gsrc); stg[1] = *(const bf16x8*)(MK + gsrc + 16 * 1024);
    bf16x8 qf[16];
#pragma unroll
    for (int ks = 0; ks < 16; ++ks) qf[ks] = *(const bf16x8*)(Q2 + (size_t)qrow * D + h * 256 + 16 * ks + 8 * hi);
    *(LAS bf16x8*)(lds + koff_x(sm0, sc0)) = stg[0]; *(LAS bf16x8*)(lds + koff_x(sm0 + 16, sc0)) = stg[1];
    __syncthreads();
    f32x16 S[8];
#pragma unroll
    for (int s = 0; s < 8; ++s) {
        LAS unsigned char* cur = lds + (s & 1) * 16384; LAS unsigned char* nxt = lds + ((s + 1) & 1) * 16384;
        const bf16_t* src = (s < 7) ? MK + (size_t)(s + 1) * 32 * 1024 : MV;
        stg[0] = *(const bf16x8*)(src + gsrc); stg[1] = *(const bf16x8*)(src + gsrc + 16 * 1024);
#pragma unroll
        for (int e = 0; e < 16; ++e) S[s][e] = 0.f;
#pragma unroll
        for (int ks = 0; ks < 16; ++ks) { const bf16x8 kf = *(const LAS bf16x8*)(cur + koff_x(r, 2 * ks + hi)); S[s] = __builtin_amdgcn_mfma_f32_32x32x16_bf16(kf, qf[ks], S[s], 0, 0, 0); }
        if (s < 7) { *(LAS bf16x8*)(nxt + koff_x(sm0, sc0)) = stg[0]; *(LAS bf16x8*)(nxt + koff_x(sm0 + 16, sc0)) = stg[1]; }
        else { *(LAS bf16x8*)(nxt + voff_x(sm0, 8 * sc0)) = stg[0]; *(LAS bf16x8*)(nxt + voff_x(sm0 + 16, 8 * sc0)) = stg[1]; }
        __syncthreads();
    }
    float mx = S[0][0];
#pragma unroll
    for (int s = 0; s < 8; ++s)
#pragma unroll
        for (int e = 0; e < 16; ++e) mx = fmaxf(mx, S[s][e]);
    mx = fmaxf(mx, __shfl_xor(mx, 32));
    float lsum = 0.f;
    bf16x8 pf[8][2];
#pragma unroll
    for (int s = 0; s < 8; ++s) {
#pragma unroll
        for (int e = 0; e < 16; ++e) { S[s][e] = __builtin_amdgcn_exp2f(S[s][e] - mx); lsum += S[s][e]; }
#pragma unroll
        for (int s2 = 0; s2 < 2; ++s2) { u32x4 w; w.x = cvt_pk_bf16(S[s][8 * s2 + 0], S[s][8 * s2 + 1]); w.y = cvt_pk_bf16(S[s][8 * s2 + 2], S[s][8 * s2 + 3]); w.z = cvt_pk_bf16(S[s][8 * s2 + 4], S[s][8 * s2 + 5]); w.w = cvt_pk_bf16(S[s][8 * s2 + 6], S[s][8 * s2 + 7]);
            pf[s][s2] = __builtin_bit_cast(bf16x8, w); }
    }
    lsum += __shfl_xor(lsum, 32);
    f32x16 O[8];
#pragma unroll
    for (int db = 0; db < 8; ++db)
#pragma unroll
        for (int e = 0; e < 16; ++e) O[db][e] = 0.f;
    const int trow = 4 * hi + ((lane & 15) >> 2), tcol = 16 * ((lane >> 4) & 1) + 4 * (lane & 3);
#pragma unroll
    for (int s = 8; s < 16; ++s) {
        LAS unsigned char* cur = lds + (s & 1) * 16384; LAS unsigned char* nxt = lds + ((s + 1) & 1) * 16384;
        if (s < 15) { const bf16_t* src = MV + (size_t)(s - 7) * 32 * 1024; stg[0] = *(const bf16x8*)(src + gsrc); stg[1] = *(const bf16x8*)(src + gsrc + 16 * 1024); }
#pragma unroll
        for (int db = 0; db < 8; ++db)
#pragma unroll
            for (int s2 = 0; s2 < 2; ++s2) {
                const s16x4 a0 = tr_read(cur + voff_x(16 * s2 + trow, 32 * db + tcol));
                const s16x4 a1 = tr_read(cur + voff_x(16 * s2 + 8 + trow, 32 * db + tcol));
                const bf16x8 vf = (bf16x8){a0[0], a0[1], a0[2], a0[3], a1[0], a1[1], a1[2], a1[3]};
                O[db] = __builtin_amdgcn_mfma_f32_32x32x16_bf16(vf, pf[s - 8][s2], O[db], 0, 0, 0);
            }
        if (s < 15) { *(LAS bf16x8*)(nxt + voff_x(sm0, 8 * sc0)) = stg[0]; *(LAS bf16x8*)(nxt + voff_x(sm0 + 16, 8 * sc0)) = stg[1]; }
        __syncthreads();
    }
    const float inv = 1.0f / lsum;
    bf16_t* op = O2 + (size_t)qrow * D + h * 256 + 4 * hi;
#pragma unroll
    for (int db = 0; db < 8; ++db)
#pragma unroll
        for (int g4 = 0; g4 < 4; ++g4) { u32x2 w; w.x = cvt_pk_bf16(O[db][4 * g4] * inv, O[db][4 * g4 + 1] * inv); w.y = cvt_pk_bf16(O[db][4 * g4 + 2] * inv, O[db][4 * g4 + 3] * inv);
            *(u32x2*)(op + 32 * db + 8 * g4) = w; }
}

__device__ __forceinline__ void xattn_sample_unit(const Params& P, int l, int b, int h, LAS unsigned char* lds, int tid_) {
    int tid = tid_; asm volatile("" : "+v"(tid));
    const int lane = tid & 63, wave = __builtin_amdgcn_readfirstlane(tid >> 6), r = lane & 31, hi = lane >> 5;
    const bf16_t* Q2 = (const bf16_t*)(P.ws + WS_Q2);
    bf16_t* O2 = (bf16_t*)(P.ws + WS_O2);
    const float* CK = P.in[7] + ((size_t)(l * 32 + b) * 256 + 32 * wave) * 1024 + h * 256;
    const float* CV = P.in[8] + ((size_t)(l * 32 + b) * 256 + 32 * wave) * 1024 + h * 256;
    LAS unsigned char* wl = lds + wave * 16384;
    LAS float* ml = (LAS float*)(lds + 131072);
    const int qrow = TP + b * 16 + (r & 15);
#pragma unroll 4
    for (int i = 0; i < 16; ++i) { const int idx = lane + 64 * i, vr = idx >> 5, ch = idx & 31;
        *(LAS bf16x8*)(wl + voff_x(vr, 8 * ch)) = load8f_bf(CV + (size_t)vr * 1024 + 8 * ch); }
    f32x16 S;
#pragma unroll
    for (int e = 0; e < 16; ++e) S[e] = 0.f;
#pragma unroll 4
    for (int ks = 0; ks < 16; ++ks) {
        const bf16x8 qf = *(const bf16x8*)(Q2 + (size_t)qrow * D + h * 256 + 16 * ks + 8 * hi);
        const bf16x8 kf = load8f_bf(CK + (size_t)r * 1024 + 16 * ks + 8 * hi);
        S = __builtin_amdgcn_mfma_f32_32x32x16_bf16(kf, qf, S, 0, 0, 0);
    }
    float mx = S[0];
#pragma unroll
    for (int e = 1; e < 16; ++e) mx = fmaxf(mx, S[e]);
    mx = fmaxf(mx, __shfl_xor(mx, 32));
    float ls = 0.f;
#pragma unroll
    for (int e = 0; e < 16; ++e) { S[e] = __builtin_amdgcn_exp2f(S[e] - mx); ls += S[e]; }
    ls += __shfl_xor(ls, 32);
    bf16x8 pf[2];
#pragma unroll
    for (int s2 = 0; s2 < 2; ++s2) { u32x4 w; w.x = cvt_pk_bf16(S[8 * s2 + 0], S[8 * s2 + 1]); w.y = cvt_pk_bf16(S[8 * s2 + 2], S[8 * s2 + 3]); w.z = cvt_pk_bf16(S[8 * s2 + 4], S[8 * s2 + 5]); w.w = cvt_pk_bf16(S[8 * s2 + 6], S[8 * s2 + 7]);
        pf[s2] = __builtin_bit_cast(bf16x8, w); }
    f32x16 O[8];
    const int trow = 4 * hi + ((lane & 15) >> 2), tcol = 16 * ((lane >> 4) & 1) + 4 * (lane & 3);
#pragma unroll
    for (int db = 0; db < 8; ++db) {
#pragma unroll
        for (int e = 0; e < 16; ++e) O[db][e] = 0.f;
#pragma unroll
        for (int s2 = 0; s2 < 2; ++s2) {
            const s16x4 a0 = tr_read(wl + voff_x(16 * s2 + trow, 32 * db + tcol));
            const s16x4 a1 = tr_read(wl + voff_x(16 * s2 + 8 + trow, 32 * db + tcol));
            const bf16x8 vf = (bf16x8){a0[0], a0[1], a0[2], a0[3], a1[0], a1[1], a1[2], a1[3]};
            O[db] = __builtin_amdgcn_mfma_f32_32x32x16_bf16(vf, pf[s2], O[db], 0, 0, 0);
        }
    }
    if (lane < 16) { ml[(wave * 16 + lane) * 2] = mx; ml[(wave * 16 + lane) * 2 + 1] = ls; }
    if (r < 16) {
        LAS float* ow = (LAS float*)wl;
#pragma unroll
        for (int db = 0; db < 8; ++db)
#pragma unroll
            for (int e = 0; e < 16; ++e) ow[(32 * db + (e & 3) + 8 * (e >> 2) + 4 * hi) * 16 + r] = O[db][e];
    }
    __syncthreads();
    {
        const int q = tid & 15, dg = tid >> 4;
        float mw[8], M = -1e30f;
#pragma unroll
        for (int w = 0; w < 8; ++w) { mw[w] = ml[(w * 16 + q) * 2]; M = fmaxf(M, mw[w]); }
        float L = 0.f, o[8];
#pragma unroll
        for (int e = 0; e < 8; ++e) o[e] = 0.f;
#pragma unroll
        for (int w = 0; w < 8; ++w) { const float sc = __builtin_amdgcn_exp2f(mw[w] - M); L += ml[(w * 16 + q) * 2 + 1] * sc;
            const LAS float* ow = (const LAS float*)(lds + w * 16384);
#pragma unroll
            for (int e = 0; e < 8; ++e) o[e] += ow[(8 * dg + e) * 16 + q] * sc; }
        const float inv = 1.0f / L;
#pragma unroll
        for (int e = 0; e < 8; ++e) o[e] *= inv;
        *(bf16x8*)(O2 + (size_t)(TP + b * 16 + q) * D + h * 256 + 8 * dg) = pack8(o);
    }
    __syncthreads();
}

__device__ __forceinline__ void xattn_phase(const Params& P, int l, LAS unsigned char* lds, int G, int vcu) {
    for (int u = vcu; u < 256; u += G) { xattn_prompt_unit(P, l, u >> 2, u & 3, lds, threadIdx.x); __syncthreads(); }
    for (int u = vcu; u < 128; u += G) xattn_sample_unit(P, l, u >> 2, u & 3, lds, threadIdx.x);
}

#define XB_TMO      128
#define XB_XCNT(j)  (256  + 64 * (j))
#define XB_XSUB(j)  (1280 + 64 * (j))
#define XB_XGEN(j)  (2304 + 64 * (j))
#define XB_TOP      3328
#define XB_TOPGEN   3392
#define XCD_BAR_WORDS 3456
#define XB_SPIN_CAP (1u << 22)
__device__ __forceinline__ unsigned xb_ld(unsigned* p)              { return __hip_atomic_load(p, __ATOMIC_RELAXED, __HIP_MEMORY_SCOPE_AGENT); }
__device__ __forceinline__ unsigned xb_add(unsigned* p, unsigned v) { return __hip_atomic_fetch_add(p, v, __ATOMIC_RELAXED, __HIP_MEMORY_SCOPE_AGENT); }
__device__ __forceinline__ unsigned xb_xcc_id() { return (unsigned)__builtin_amdgcn_s_getreg((3 << 11) | 20) & 0xFu; }
#define XB_SPIN(cond, bar) do { unsigned _sp = 0; while (cond) { __builtin_amdgcn_s_sleep(1); \
    if ((++_sp & 255u) == 0u) { if (xb_ld(&(bar)[XB_TMO])) break; if (_sp > XB_SPIN_CAP) { atomicAdd(&(bar)[XB_TMO], 1u); break; } } } } while (0)
struct XcdBarrier { unsigned* bar; unsigned x; volatile LAS unsigned* st; };
__device__ __forceinline__ XcdBarrier xcd_barrier_post(unsigned* bar, volatile LAS unsigned* st) {
    XcdBarrier b; b.bar = bar; b.x = xb_xcc_id(); b.st = st;
    if (threadIdx.x == 0) (void)xb_add(&bar[XB_XCNT(b.x)], 1u);
    return b;
}
__device__ __forceinline__ void xcd_barrier_complete(unsigned* bar, unsigned x, unsigned& nloc, unsigned& nx) {
    const unsigned G = gridDim.x * gridDim.y * gridDim.z;
    unsigned sum, cnt, mine, sp = 0u;
    for (;;) {
        sum = 0u; cnt = 0u; mine = 0u;
#pragma unroll
        for (unsigned j = 0; j < 16; ++j) { const unsigned c = xb_ld(&bar[XB_XCNT(j)]); sum += c; cnt += (c > 0u) ? 1u : 0u; mine = (j == x) ? c : mine; }
        if (sum == G) break;
        __builtin_amdgcn_s_sleep(1);
        if ((++sp & 255u) == 0u) { if (xb_ld(&bar[XB_TMO])) break; if (sp > XB_SPIN_CAP) { atomicAdd(&bar[XB_TMO], 1u); break; } }
    }
    nloc = mine > 0u ? mine : 1u; nx = cnt > 0u ? cnt : 1u;
}
__device__ __forceinline__ void xcd_barrier(const XcdBarrier& b) {
    asm volatile("s_waitcnt vmcnt(0)" ::: "memory");
    __syncthreads();
    if (threadIdx.x == 0) {
        unsigned* bar = b.bar; unsigned bx_ = b.x; asm volatile("" : "+s"(bar), "+s"(bx_));
        __builtin_amdgcn_s_waitcnt(0);
        unsigned nloc = b.st[0], nx = b.st[1];
        if (nloc == 0u) { xcd_barrier_complete(bar, bx_, nloc, nx); b.st[0] = nloc; b.st[1] = nx; }
        const unsigned old = xb_add(&bar[XB_XSUB(bx_)], 1u);
        const unsigned gen = old / nloc;
        if (old + 1u == (gen + 1u) * nloc) {
            __builtin_amdgcn_fence(__ATOMIC_RELEASE, "agent");
            asm volatile("s_waitcnt vmcnt(0)" ::: "memory");
            const unsigned og = xb_add(&bar[XB_TOP], 1u);
            const unsigned tg = og / nx;
            if (og + 1u == (tg + 1u) * nx) xb_add(&bar[XB_TOPGEN], 1u);
            else XB_SPIN(xb_ld(&bar[XB_TOPGEN]) == tg, bar);
            __builtin_amdgcn_fence(__ATOMIC_ACQUIRE, "agent");
            xb_add(&bar[XB_XGEN(bx_)], 1u);
            asm volatile("s_waitcnt vmcnt(0)" ::: "memory");
        } else {
            XB_SPIN(xb_ld(&bar[XB_XGEN(bx_)]) == gen, bar);
            __builtin_amdgcn_fence(__ATOMIC_ACQUIRE, "agent");
            asm volatile("s_waitcnt vmcnt(0)" ::: "memory");
        }
    }
    __syncthreads();
}

__global__ void __launch_bounds__(512, 2) mega_fwd(Params P) {
    extern __shared__ __attribute__((aligned(16))) unsigned char lds_raw[];
    LAS unsigned char* lds = (LAS unsigned char*)lds_raw;
    cg::grid_group grid = cg::this_grid();
    const int G = gridDim.x, bx = blockIdx.x;
    const int vcu = (G % 8 == 0) ? (bx % 8) * (G / 8) + bx / 8 : bx;
    unsigned char* ws0 = P.ws;

    volatile LAS unsigned* bst = (volatile LAS unsigned*)(lds + 131072 + 8192);
    if (threadIdx.x < 2) bst[threadIdx.x] = 0u;
    __syncthreads();
    XcdBarrier xbar = xcd_barrier_post((unsigned*)(ws0 + WS_CTL), bst);
    prologue(P, lds, G, vcu);
    if (P.ws == nullptr) grid.sync();
    xcd_barrier(xbar);

    for (int step = 0; step < 36; ++step) {
        const int l = step / 9; int s = step % 9; if (s >= 6) ++s;
        unsigned char* ws = ws0; asm volatile("" : "+s"(ws));
        float* X = (float*)(ws + WS_X); bf16_t* XB = (bf16_t*)(ws + WS_XB); float* SS = (float*)(ws + WS_SS);
        bf16_t* ACT = (bf16_t*)(ws + WS_ACT); bf16_t* Z = (bf16_t*)(ws + WS_Z); bf16_t* MIX = (bf16_t*)(ws + WS_MIX);
        bf16_t* Q2 = (bf16_t*)(ws + WS_Q2); bf16_t* O2 = (bf16_t*)(ws + WS_O2);
        if (s == 0 || s == 8) {
            const int f = 2 * l + (s == 8);
            pg8::Gemm g{XB, (const bf16_t*)(ws + WS_W1) + (size_t)f * 2 * DFF * D, T, 2 * DFF, D};
            pg8::StaticOrder S; S.init(T, 2 * DFF, G, bx);
            pg8::EpiSwiglu E{ACT};
            pg8::gemm_phase(lds, g, S, E, SS);
        }
        if (s == 2 || s == 5 || step == 0) {
            pg8::Gemm g; pg8::StaticOrder S; pg8::EpiScale E; const float* ssp = SS;
            if (step == 0) { ssp = (const float*)(ws + WS_SSM); g = pg8::Gemm{(const bf16_t*)(ws + WS_MEMB), (const bf16_t*)(ws + WS_WKV), 512, 8192, D}; S.init(512, 8192, G, (bx + 64) % G);
                E = pg8::EpiScale{(bf16_t*)(ws + WS_MEMKV), 1024, 1.0f, 1, P.out + OFF_MK}; }
            else if (s == 2) { g = pg8::Gemm{XB, (const bf16_t*)(ws + WS_WIN) + (size_t)l * DIN * D, T, DIN, D}; S.init(T, DIN, G, bx);
                E = pg8::EpiScale{Z, DIN, 1.0f, 0, nullptr}; }
            else { g = pg8::Gemm{XB, (const bf16_t*)(ws + WS_WXQ) + (size_t)l * D * D, TP, D, D}; S.init(TP, D, G, bx);
                E = pg8::EpiScale{Q2, D, 0.0625f * LOG2E, 0, nullptr}; }
            pg8::gemm_phase(lds, g, S, E, ssp);
            if (s == 5) {
                asm volatile("s_waitcnt vmcnt(0)" ::: "memory"); __syncthreads();
                pg8::Unit uq;
                for (int i = 0; S.next(i, uq); ++i) { xattn_prompt_unit(P, l, uq.pm, uq.pn, lds, threadIdx.x); __syncthreads(); }
                for (int u = bx; u < 128; u += G) {
                    small_gemm_q256(lds, g.A, g.Bt, u, SS, 0.0625f * LOG2E, Q2);
                    xattn_sample_unit(P, l, u >> 2, u & 3, lds, threadIdx.x);
                }
            }
        }
        if (s == 1 || s == 9 || s == 4 || s == 7) {
            pg8::Gemm g; float sc = 1.0f;
            if (s == 1 || s == 9) { g = pg8::Gemm{ACT, (const bf16_t*)(ws + WS_WD) + (size_t)(2 * l + (s == 9)) * D * DFF, TP, D, DFF}; sc = 0.5f; }
            else if (s == 4) g = pg8::Gemm{MIX, (const bf16_t*)(ws + WS_WOUT) + (size_t)l * D * D, TP, D, D};
            else g = pg8::Gemm{O2, (const bf16_t*)(ws + WS_WXO) + (size_t)l * D * D, TP, D, D};
            pg8::StaticOrder S; S.init(TP, D, G, bx);
            pg8::EpiResid E{X, XB, SS, sc};
            pg8::gemm_phase(lds, g, S, E, nullptr);
            for (int u = bx; u < 256; u += G) small_gemm<0>(lds, g.A, g.Bt, g.K, u, X, XB, SS, sc, nullptr);
        }
        if (s == 0 || s == 2 || (s == 8 && l < NL - 1)) {
            const int cl = s == 8 ? l + 1 : l, p0 = s == 8 ? 0 : (s == 0 ? (step == 0 ? 0 : 30) : 60), p1 = s == 8 ? 30 : (s == 0 ? 60 : 100);
            int c0 = s == 2 ? 148 : 172; if (G <= c0) c0 = 0;
            if (bx >= c0) cache_convert(P, cl, p0, p1, bx - c0, G - c0);
        }
#ifndef NO_MIXER
        if (s == 3) mixer_phase(P, l, lds, G, vcu);
#endif
        xcd_barrier(xbar);
    }
    {
        int tid = threadIdx.x; asm volatile("" : "+v"(tid));
        const int lane = tid & 63, wave = tid >> 6;
        const float* X = (const float*)(ws0 + WS_X);
        const float* gf = P.in[31];
        for (int m = vcu * NW + wave; m < T; m += G * NW) {
            const u32x2* xr = (const u32x2*)((const bf16_t*)(ws0 + WS_XB) + (size_t)m * D);
            f32x4 v[4]; float ss = 0.f;
#pragma unroll
            for (int j = 0; j < 4; ++j) { const u32x2 xw = xr[lane + 64 * j]; v[j] = (f32x4){bf_lo(xw.x), bf_hi(xw.x), bf_lo(xw.y), bf_hi(xw.y)}; ss += (v[j][0] * v[j][0] + v[j][1] * v[j][1]) + (v[j][2] * v[j][2] + v[j][3] * v[j][3]); }
            ss = wave_sum(ss);
            const float rs = __builtin_amdgcn_rsqf(ss * (1.0f / 1024.0f) + EPS);
#pragma unroll
            for (int j = 0; j < 4; ++j) { const f32x4 gg = ((const f32x4*)gf)[lane + 64 * j]; ((f32x4*)(P.out + OFF_Y + (size_t)m * D))[lane + 64 * j] = v[j] * rs * gg; }
        }
    }
}

constexpr int LDS_BYTES = 131072 + 8192 + 64;
extern "C" void kernel_launch(void* const* d_in, const int* in_sizes, int n_in, void* d_out, int out_size, void* d_ws, size_t ws_size, hipStream_t stream) {
    static int grid = 0;
    if (grid == 0) {
        if (n_in != 32 || (size_t)out_size != OUT_TOTAL || ws_size < WS_END) { fprintf(stderr, "kernel_launch: unexpected sizes n_in %d out %d ws %zu (need %zu)\n", n_in, out_size, ws_size, (size_t)WS_END); grid = -1; return; }
        int dev = 0, cus = 0, per_cu = 0;
        hipGetDevice(&dev);
        hipDeviceGetAttribute(&cus, hipDeviceAttributeMultiprocessorCount, dev);
        if (hipFuncSetAttribute((const void*)mega_fwd, hipFuncAttributeMaxDynamicSharedMemorySize, LDS_BYTES) != hipSuccess) { fprintf(stderr, "kernel_launch: hipFuncSetAttribute failed\n"); grid = -1; return; }
        if (hipOccupancyMaxActiveBlocksPerMultiprocessor(&per_cu, (const void*)mega_fwd, 512, LDS_BYTES) != hipSuccess || per_cu < 1) { fprintf(stderr, "kernel_launch: occupancy query says %d\n", per_cu); per_cu = 1; }
        (void)hipGetLastError();
        grid = cus;
    }
    if (grid < 0) return;
    if (hipMemsetAsync((char*)d_ws + WS_CTL, 0, 16384, stream) != hipSuccess) { fprintf(stderr, "kernel_launch: memset failed\n"); return; }
    Params p{};
    for (int i = 0; i < 32; ++i) p.in[i] = (const float*)d_in[i];
    p.out = (float*)d_out; p.ws = (unsigned char*)d_ws;
    void* args[] = {&p};
    hipError_t e = hipLaunchCooperativeKernel((const void*)mega_fwd, dim3(grid), dim3(512), args, LDS_BYTES, stream);
    if (e != hipSuccess) fprintf(stderr, "cooperative launch failed: %s (grid %d)\n", hipGetErrorString(e), grid);
}
```

```cpp
#include <hip/hip_runtime.h>
#include <hip/hip_cooperative_groups.h>
#include <cstdio>
#include <cstdint>
namespace cg = cooperative_groups;

#define LAS __attribute__((address_space(3)))
typedef unsigned short bf16_t;
typedef short bf16x8 __attribute__((ext_vector_type(8)));
typedef short s16x4 __attribute__((ext_vector_type(4)));
typedef float f32x4 __attribute__((ext_vector_type(4)));
typedef float f32x16 __attribute__((ext_vector_type(16)));
typedef unsigned u32x4 __attribute__((ext_vector_type(4)));
typedef unsigned u32x2 __attribute__((ext_vector_type(2)));

constexpr int D = 1024, SEQ = 8192, TP = 2 * SEQ, TS = 512, T = TP + TS, DFF = 2816, DIN = 2560, NL = 4;
constexpr int NW = 8;
constexpr float EPS = 1e-6f, LOG2E = 1.4426950408889634f;
constexpr size_t OFF_Y = 0;
constexpr size_t OFF_KP = (size_t)T * D;
constexpr size_t OFF_VP = OFF_KP + (size_t)NL * 2 * 512 * 512;
constexpr size_t OFF_CP = OFF_VP + (size_t)NL * 2 * 512 * 512;
constexpr size_t OFF_PP = OFF_CP + (size_t)NL * 2 * 2 * 256;
constexpr size_t OFF_MK = OFF_PP + (size_t)NL * 2 * 15 * 256;
constexpr size_t OFF_MV = OFF_MK + (size_t)NL * 512 * 1024;
constexpr size_t OFF_KS = OFF_MV + (size_t)NL * 512 * 1024;
constexpr size_t OFF_VS = OFF_KS + (size_t)NL * 32 * 512 * 512;
constexpr size_t OFF_CS = OFF_VS + (size_t)NL * 32 * 512 * 512;
constexpr size_t OFF_PS = OFF_CS + (size_t)NL * 32 * 2 * 256;
constexpr size_t OUT_TOTAL = OFF_PS + (size_t)NL * 32 * 15 * 256;
static_assert(OUT_TOTAL == 93390848, "output size");

constexpr size_t al(size_t x) { return (x + 1048575) & ~(size_t)1048575; }
constexpr size_t WS_X = 0;
constexpr size_t WS_XB = WS_X + al((size_t)T * D * 4);
constexpr size_t WS_SS = WS_XB + al((size_t)T * D * 2);
constexpr size_t WS_ACT = WS_SS + al((size_t)T * 16 * 4);
constexpr size_t WS_Z = WS_ACT + al((size_t)T * DFF * 2);
constexpr size_t WS_MIX = WS_Z + al((size_t)T * DIN * 2);
constexpr size_t WS_Q2 = WS_MIX + al((size_t)T * D * 2);
constexpr size_t WS_O2 = WS_Q2 + al((size_t)T * D * 2);
constexpr size_t WS_MEMB = WS_O2 + al((size_t)T * D * 2);
constexpr size_t WS_SSM = WS_MEMB + al((size_t)512 * D * 2);
constexpr size_t WS_MEMKV = WS_SSM + al((size_t)512 * 16 * 4);
constexpr size_t WS_W1 = WS_MEMKV + al((size_t)8 * 512 * D * 2);
constexpr size_t WS_WD = WS_W1 + al((size_t)8 * 2 * DFF * D * 2);
constexpr size_t WS_WIN = WS_WD + al((size_t)8 * D * DFF * 2);
constexpr size_t WS_WOUT = WS_WIN + al((size_t)NL * DIN * D * 2);
constexpr size_t WS_WXQ = WS_WOUT + al((size_t)NL * D * D * 2);
constexpr size_t WS_WXO = WS_WXQ + al((size_t)NL * D * D * 2);
constexpr size_t WS_WKV = WS_WXO + al((size_t)NL * D * D * 2);
constexpr size_t WS_PWT = WS_WKV + al((size_t)NL * 2 * D * D * 2);
constexpr size_t WS_HZC = WS_PWT + al((size_t)NL * 4 * 64 * 64 * 2);
constexpr size_t WS_HZP = WS_HZC + al((size_t)NL * 32 * 2 * 256 * 2);
constexpr size_t WS_KB16 = WS_HZP + al((size_t)NL * 32 * 15 * 256 * 2);
constexpr size_t WS_VB16 = WS_KB16 + al((size_t)NL * 32 * 512 * 512 * 2);
constexpr size_t WS_CTL = WS_VB16 + al((size_t)NL * 32 * 512 * 512 * 2);
constexpr size_t WS_END = WS_CTL + al(65536);

struct Params {
    const float* in[32];
    float* out;
    unsigned char* ws;
};

__device__ __forceinline__ unsigned cvt_pk_bf16(float lo, float hi) { unsigned r; asm("v_cvt_pk_bf16_f32 %0, %1, %2" : "=v"(r) : "v"(lo), "v"(hi)); return r; }
__device__ __forceinline__ float bf_lo(unsigned w) { return __uint_as_float(w << 16); }
__device__ __forceinline__ float bf_hi(unsigned w) { return __uint_as_float(w & 0xffff0000u); }
__device__ __forceinline__ void unpack8(bf16x8 v, float* f) {
    u32x4 w = __builtin_bit_cast(u32x4, v);
    f[0] = bf_lo(w.x); f[1] = bf_hi(w.x); f[2] = bf_lo(w.y); f[3] = bf_hi(w.y);
    f[4] = bf_lo(w.z); f[5] = bf_hi(w.z); f[6] = bf_lo(w.w); f[7] = bf_hi(w.w);
}
__device__ __forceinline__ bf16x8 pack8(const float* f) {
    u32x4 w; w.x = cvt_pk_bf16(f[0], f[1]); w.y = cvt_pk_bf16(f[2], f[3]); w.z = cvt_pk_bf16(f[4], f[5]); w.w = cvt_pk_bf16(f[6], f[7]);
    return __builtin_bit_cast(bf16x8, w);
}
__device__ __forceinline__ bf16x8 pack8v(f32x4 a, f32x4 b) {
    u32x4 w; w.x = cvt_pk_bf16(a[0], a[1]); w.y = cvt_pk_bf16(a[2], a[3]); w.z = cvt_pk_bf16(b[0], b[1]); w.w = cvt_pk_bf16(b[2], b[3]);
    return __builtin_bit_cast(bf16x8, w);
}
__device__ __forceinline__ float wave_sum(float v) {
#pragma unroll
    for (int o = 1; o < 64; o <<= 1) v += __shfl_xor(v, o);
    return v;
}
__device__ __forceinline__ float row_rstd(const float* SS, int row) {
    const f32x4* p = (const f32x4*)(SS + (size_t)row * 16);
    const f32x4 a = p[0], b = p[1], c = p[2], d = p[3];
    const float s = ((a[0] + a[1]) + (a[2] + a[3])) + ((b[0] + b[1]) + (b[2] + b[3])) + ((c[0] + c[1]) + (c[2] + c[3])) + ((d[0] + d[1]) + (d[2] + d[3]));
    return __builtin_amdgcn_rsqf(s * (1.0f / 1024.0f) + EPS);
}
__device__ __forceinline__ s16x4 tr_read(LAS unsigned char* p) {
    return __builtin_amdgcn_ds_read_tr16_b64_v4i16((LAS s16x4*)p);
}

namespace pg8 {
constexpr int BM = 256, BK = 64, HALF = 128, HTB = HALF * BK * 2, STAGE_BYTES = 8 * HTB, NXCD = 8, WGM = 8;
__host__ __device__ __forceinline__ int lds_byte(int r, int c) { const int st = (r >> 4) * 2 + (c >> 5), rr = r & 15, cc = c & 31, ob = rr * 64 + cc * 2; return st * 1024 + (ob ^ (((ob >> 9) & 1) << 5)); }
__host__ __device__ __forceinline__ void stage_rc(int b, int& R, int& C) { const int st = b / 1024, sb = b % 1024, swz = sb ^ (((sb >> 9) & 1) << 5); R = (st >> 1) * 16 + swz / 64; C = (st & 1) * 32 + (swz % 64) / 2; }
__host__ __device__ __forceinline__ int perm32(int rho) { const int n = rho >> 4, i = rho & 15; return 8 * (i >> 2) + 4 * n + (i & 3); }

struct Unit { int pm, pn; };
struct Gemm { const bf16_t* A; const bf16_t* Bt; int M, N, K; };

struct StaticOrder {
    int nM, nN, nwg, G, c;
    __device__ void init(int M, int N, int G_, int c_) { nM = M / BM; nN = N / BM; nwg = nM * nN; G = G_; c = c_; }
    __device__ bool next(int i, Unit& u) const {
        const long L = (long)i * G + c; if (L >= nwg) return false;
        int wgid = (int)L; { const int q = nwg / NXCD, r = nwg % NXCD, xcd = wgid % NXCD, off = wgid / NXCD; wgid = (xcd < r ? xcd * (q + 1) : r * (q + 1) + (xcd - r) * q) + off; }
        const int nig = WGM * nN, gid = wgid / nig, fm = gid * WGM, gsz = (nM - fm) < WGM ? (nM - fm) : WGM;
        u.pm = fm + ((wgid % nig) % gsz); u.pn = (wgid % nig) / gsz; return true;
    }
};

struct EpiSwiglu {
    bf16_t* O;
    __device__ __forceinline__ void operator()(const f32x4 (&acc)[2][2][4][2], const Unit& u, const LAS float* rsl, int wr, int wc, int fr, int fq) const {
        const int col0 = u.pn * 128 + wc * 32 + 8 * fq;
#pragma unroll
        for (int ai = 0; ai < 2; ++ai)
#pragma unroll
            for (int m = 0; m < 4; ++m) {
                const int rl = ai * HALF + wr * 64 + m * 16 + fr, row = u.pm * BM + rl;
                const float rs = rsl[rl];
                float o[8];
#pragma unroll
                for (int n = 0; n < 2; ++n)
#pragma unroll
                    for (int e = 0; e < 4; ++e) {
                        const float g = acc[ai][0][m][n][e] * rs, up = acc[ai][1][m][n][e] * rs;
                        const float sg = g * __builtin_amdgcn_rcpf(1.0f + __builtin_amdgcn_exp2f(-g * LOG2E));
                        o[n * 4 + e] = sg * up;
                    }
                *(bf16x8*)(O + (size_t)row * DFF + col0) = pack8(o);
            }
    }
};
struct EpiResid {
    float* X; bf16_t* XB; float* SS; float s;
    __device__ __forceinline__ void operator()(const f32x4 (&acc)[2][2][4][2], const Unit& u, const LAS float* rsl, int wr, int wc, int fr, int fq) const {
        bf16_t* base = XB + (size_t)(u.pm * BM + wr * 64 + fr) * D + u.pn * BM + wc * 32 + 8 * fq;
        bf16x8 xin[2][4][2];
#pragma unroll
        for (int ai = 0; ai < 2; ++ai)
#pragma unroll
            for (int m = 0; m < 4; ++m)
#pragma unroll
                for (int bj = 0; bj < 2; ++bj) xin[ai][m][bj] = *(const bf16x8*)(base + (size_t)(ai * HALF + m * 16) * D + bj * HALF);
#pragma unroll
        for (int ai = 0; ai < 2; ++ai)
#pragma unroll
            for (int m = 0; m < 4; ++m) {
                const int row = u.pm * BM + ai * HALF + wr * 64 + m * 16 + fr;
                float ss = 0.f;
#pragma unroll
                for (int bj = 0; bj < 2; ++bj) {
                    float xf[8]; unpack8(xin[ai][m][bj], xf);
                    f32x4 x0 = (f32x4){xf[0], xf[1], xf[2], xf[3]}, x1 = (f32x4){xf[4], xf[5], xf[6], xf[7]};
                    x0 += acc[ai][bj][m][0] * s; x1 += acc[ai][bj][m][1] * s;
                    *(bf16x8*)(base + (size_t)(ai * HALF + m * 16) * D + bj * HALF) = pack8v(x0, x1);
                    ss += (x0[0] * x0[0] + x0[1] * x0[1]) + (x0[2] * x0[2] + x0[3] * x0[3]) + (x1[0] * x1[0] + x1[1] * x1[1]) + (x1[2] * x1[2] + x1[3] * x1[3]);
                }
                ss += __shfl_xor(ss, 16); ss += __shfl_xor(ss, 32);
                if (fq == 0) SS[(size_t)row * 16 + u.pn * 4 + wc] = ss;
            }
    }
};
struct EpiScale {
    bf16_t* O; int ldc; float cs; int mode; float* out32;
    __device__ __forceinline__ void operator()(const f32x4 (&acc)[2][2][4][2], const Unit& u, const LAS float* rsl, int wr, int wc, int fr, int fq) const {
#pragma unroll
        for (int ai = 0; ai < 2; ++ai)
#pragma unroll
            for (int m = 0; m < 4; ++m) {
                const int rl = ai * HALF + wr * 64 + m * 16 + fr, row = u.pm * BM + rl;
                const float rs = rsl[rl] * cs;
#pragma unroll
                for (int bj = 0; bj < 2; ++bj) {
                    const int col = u.pn * BM + bj * HALF + wc * 32 + 8 * fq;
                    const f32x4 v0 = acc[ai][bj][m][0] * rs, v1 = acc[ai][bj][m][1] * rs;
                    if (mode == 0) {
                        *(bf16x8*)(O + (size_t)row * ldc + col) = pack8v(v0, v1);
                    } else {
                        const int t = col >> 10, c = col & 1023;
                        *(bf16x8*)(O + ((size_t)t * 512 + row) * 1024 + c) = pack8v(v0, v1);
                        float* o = out32 + (size_t)(t & 1) * (OFF_MV - OFF_MK) + (size_t)(t >> 1) * (512 * 1024) + (size_t)row * 1024 + c;
                        *(f32x4*)o = v0; *(f32x4*)(o + 4) = v1;
                    }
                }
            }
    }
};

template <class Epi>
__device__ __forceinline__ void gemm_phase(LAS unsigned char* lds, const Gemm g, const StaticOrder& S, const Epi& E, const float* SS) {
    int tid = threadIdx.x; asm volatile("" : "+v"(tid));
    LAS float* rsl = (LAS float*)(lds + STAGE_BYTES);
    const int wid = __builtin_amdgcn_readfirstlane(tid >> 6), lane = tid & 63, wr = wid >> 2, wc = wid & 3, fr = lane & 15, fq = lane >> 4;
    const int K = g.K, nt = K / BK;
    unsigned voffA[2], voffB[2];
#pragma unroll
    for (int i = 0; i < 2; ++i) { int R, C; stage_rc(tid * 16 + i * 8192, R, C); const int Rb = (R & ~31) + perm32(R & 31);
        voffA[i] = (unsigned)(R * K + C) * 2u; voffB[i] = (unsigned)(Rb * K + C) * 2u; }
    const size_t kstep = (size_t)(BK * 2);
    const size_t hstep = (size_t)HALF * K * 2;
    const size_t tstep = 2 * hstep;
    const unsigned ldsw = (unsigned)wid * 1024u;
    const int aoff = lds_byte(wr * 64 + fr, fq * 8), boff = lds_byte(wc * 32 + fr, fq * 8);
#define PG8_SA(b, h) (((b) * 2 + (h)) * HTB)
#define PG8_SB(b, h) ((4 + (b) * 2 + (h)) * HTB)
#define PG8_STAGE(bufoff, gbase, voff) do { _Pragma("unroll") for (int _i = 0; _i < 2; ++_i) \
        __builtin_amdgcn_global_load_lds((const unsigned*)((const char*)(gbase) + (voff)[_i]), (LAS unsigned*)(lds + (bufoff) + ldsw + _i * 8192), 16, 0, 0); } while (0)
#define PG8_LDA(dst, b, h) do { _Pragma("unroll") for (int m = 0; m < 4; ++m) _Pragma("unroll") for (int k = 0; k < 2; ++k) dst[m][k] = *(const LAS bf16x8*)(lds + PG8_SA(b, h) + aoff + m * 2048 + k * 1024); } while (0)
#define PG8_LDB(dst, b, h) do { _Pragma("unroll") for (int n = 0; n < 2; ++n) _Pragma("unroll") for (int k = 0; k < 2; ++k) dst[n][k] = *(const LAS bf16x8*)(lds + PG8_SB(b, h) + boff + n * 2048 + k * 1024); } while (0)
#define PG8_MMA(ai, bj, At, Bt) do { __builtin_amdgcn_s_setprio(1); _Pragma("unroll") for (int m = 0; m < 4; ++m) _Pragma("unroll") for (int n = 0; n < 2; ++n) _Pragma("unroll") for (int k = 0; k < 2; ++k) \
        acc[ai][bj][m][n] = __builtin_amdgcn_mfma_f32_16x16x32_bf16(Bt[n][k], At[m][k], acc[ai][bj][m][n], 0, 0, 0); __builtin_amdgcn_s_setprio(0); } while (0)
#define PG8_WAIT_V(n) asm volatile("s_waitcnt vmcnt(" #n ")" ::: "memory")
#define PG8_WAIT_L(n) asm volatile("s_waitcnt lgkmcnt(" #n ")" ::: "memory")
#define PG8_BAR __builtin_amdgcn_s_barrier()
#define PG8_SCHED __builtin_amdgcn_sched_barrier(0)
    Unit cur, nxt; int ui = 0;
    if (!S.next(0, cur)) return;
    f32x4 acc[2][2][4][2];
#pragma unroll
    for (int a = 0; a < 2; ++a)
#pragma unroll
        for (int b = 0; b < 2; ++b)
#pragma unroll
            for (int m = 0; m < 4; ++m)
#pragma unroll
                for (int n = 0; n < 2; ++n) acc[a][b][m][n] = (f32x4){0.f, 0.f, 0.f, 0.f};
    bf16x8 At[4][2], B0[2][2], B1[2][2];
    const char* cA = (const char*)g.A + (size_t)cur.pm * tstep; const char* cB = (const char*)g.Bt + (size_t)cur.pn * tstep;
    PG8_STAGE(PG8_SB(0, 0), cB, voffB); PG8_STAGE(PG8_SB(0, 1), cB + hstep, voffB); PG8_STAGE(PG8_SA(0, 0), cA, voffA); PG8_STAGE(PG8_SA(0, 1), cA + hstep, voffA);
    if (SS) {
        int pms[8];
#pragma unroll
        for (int i = 0; i < 8; ++i) { Unit uu; pms[i] = S.next(i, uu) ? uu.pm : -1; }
        if (tid < 256) {
            f32x4 v[8][4];
#pragma unroll
            for (int i = 0; i < 8; ++i) if (pms[i] >= 0) { const f32x4* p = (const f32x4*)(SS + (size_t)(pms[i] * BM + tid) * 16);
#pragma unroll
                for (int q = 0; q < 4; ++q) v[i][q] = p[q]; }
#pragma unroll
            for (int i = 0; i < 8; ++i) if (pms[i] >= 0) { float sm = 0.f;
#pragma unroll
                for (int q = 0; q < 4; ++q) sm += (v[i][q][0] + v[i][q][1]) + (v[i][q][2] + v[i][q][3]);
                rsl[i * 256 + tid] = __builtin_amdgcn_rsqf(sm * (1.0f / 1024.0f) + EPS); }
        }
        __syncthreads();
    }
    if (wr == 1) PG8_BAR;
    PG8_WAIT_V(2); PG8_BAR;
    PG8_STAGE(PG8_SB(1, 0), cB + kstep, voffB); PG8_STAGE(PG8_SA(1, 0), cA + kstep, voffA); PG8_STAGE(PG8_SB(1, 1), cB + hstep + kstep, voffB);
    PG8_WAIT_V(6); PG8_BAR;
    for (;;) {
        const bool has_next = S.next(ui + 1, nxt);
        const char* nA = has_next ? (const char*)g.A + (size_t)nxt.pm * tstep : cA; const char* nB = has_next ? (const char*)g.Bt + (size_t)nxt.pn * tstep : cB;
        for (int t = 0; t < nt; t += 2) {
            const bool last = (t == nt - 2);
            const char* a1 = cA + (size_t)(t + 1) * kstep;
            const char* a2 = last ? nA : cA + (size_t)(t + 2) * kstep; const char* b2 = last ? nB : cB + (size_t)(t + 2) * kstep;
            const char* a3 = a2 + kstep; const char* b3 = b2 + kstep;
            PG8_LDB(B0, 0, 0); PG8_LDB(B1, 0, 1); PG8_SCHED; PG8_LDA(At, 0, 0); PG8_STAGE(PG8_SA(1, 1), a1 + hstep, voffA);
            PG8_WAIT_V(8); PG8_WAIT_L(0); PG8_BAR; PG8_MMA(0, 0, At, B0); PG8_MMA(0, 1, At, B1); PG8_BAR; PG8_SCHED;
            PG8_LDA(At, 0, 1); PG8_STAGE(PG8_SB(0, 0), b2, voffB); PG8_STAGE(PG8_SB(0, 1), b2 + hstep, voffB); PG8_STAGE(PG8_SA(0, 0), a2, voffA);
            PG8_WAIT_V(8); PG8_WAIT_L(0); PG8_BAR; PG8_MMA(1, 0, At, B0); PG8_MMA(1, 1, At, B1); PG8_BAR; PG8_SCHED;
            PG8_LDB(B0, 1, 0); PG8_LDB(B1, 1, 1); PG8_SCHED; PG8_LDA(At, 1, 0); PG8_STAGE(PG8_SA(0, 1), a2 + hstep, voffA);
            PG8_WAIT_V(8); PG8_WAIT_L(0); PG8_BAR; PG8_MMA(0, 0, At, B0); PG8_MMA(0, 1, At, B1); PG8_BAR; PG8_SCHED;
            PG8_LDA(At, 1, 1); PG8_STAGE(PG8_SB(1, 0), b3, voffB); PG8_STAGE(PG8_SB(1, 1), b3 + hstep, voffB); PG8_STAGE(PG8_SA(1, 0), a3, voffA);
            PG8_WAIT_V(8); PG8_WAIT_L(0); PG8_BAR; PG8_MMA(1, 0, At, B0); PG8_MMA(1, 1, At, B1); PG8_BAR; PG8_SCHED;
        }
        if (wr == 0) PG8_BAR;
        E(acc, cur, rsl + ui * 256, wr, wc, fr, fq);
        if (!has_next) break;
#pragma unroll
        for (int a = 0; a < 2; ++a)
#pragma unroll
            for (int b = 0; b < 2; ++b)
#pragma unroll
                for (int m = 0; m < 4; ++m)
#pragma unroll
                    for (int n = 0; n < 2; ++n) acc[a][b][m][n] = (f32x4){0.f, 0.f, 0.f, 0.f};
        cur = nxt; cA = nA; cB = nB; ++ui;
        if (wr == 1) PG8_BAR;
    }
    PG8_WAIT_V(0);
    PG8_BAR;
#undef PG8_SA
#undef PG8_SB
#undef PG8_STAGE
#undef PG8_LDA
#undef PG8_LDB
#undef PG8_MMA
#undef PG8_WAIT_V
#undef PG8_WAIT_L
#undef PG8_BAR
#undef PG8_SCHED
}
}

template <int MODE>
__device__ __forceinline__ void small_gemm(LAS unsigned char* lds, const bf16_t* A, const bf16_t* Bt, int K, int unit, float* X, bf16_t* XB, float* SS, float sc, bf16_t* OUT) {
    int tid = threadIdx.x; asm volatile("" : "+v"(tid));
    const int wave = __builtin_amdgcn_readfirstlane(tid >> 6), lane = tid & 63, li = lane & 15, g4 = lane >> 4;
    const int rt = unit >> 3, ct = unit & 7, row0 = TP + 16 * rt, col0 = 128 * ct;
    const int KS = K >> 8;
    const int row = tid >> 5, c4 = (tid & 31) * 4;
    const size_t off = (size_t)(row0 + row) * D + col0 + c4;
    u32x2 xw; f32x4 sv[4];
    if (MODE == 0) xw = *(const u32x2*)(XB + off);
    else {
#pragma unroll
        for (int q = 0; q < 4; ++q) sv[q] = ((const f32x4*)(SS + (size_t)(row0 + row) * 16))[q]; }
    f32x4 acc[8];
#pragma unroll
    for (int t = 0; t < 8; ++t) acc[t] = (f32x4){0.f, 0.f, 0.f, 0.f};
    const bf16_t* ap = A + (size_t)(row0 + li) * K + 8 * g4 + 32 * wave * KS;
    const bf16_t* bp = Bt + (size_t)(col0 + li) * K + 8 * g4 + 32 * wave * KS;
#pragma unroll 4
    for (int ks = 0; ks < KS; ++ks) {
        const bf16x8 a = *(const bf16x8*)(ap + 32 * ks);
#pragma unroll
        for (int t = 0; t < 8; ++t) { const bf16x8 b = *(const bf16x8*)(bp + (size_t)16 * t * K + 32 * ks); acc[t] = __builtin_amdgcn_mfma_f32_16x16x32_bf16(b, a, acc[t], 0, 0, 0); }
    }
    LAS float* red = (LAS float*)lds;
#pragma unroll
    for (int t = 0; t < 8; ++t) *(LAS f32x4*)(red + (wave * 16 + li) * 128 + 16 * t + 4 * g4) = acc[t];
    __syncthreads();
    f32x4 sum = *(LAS f32x4*)(red + row * 128 + c4);
#pragma unroll
    for (int w = 1; w < 8; ++w) sum += *(LAS f32x4*)(red + (w * 16 + row) * 128 + c4);
    if (MODE == 0) {
        f32x4 x = (f32x4){bf_lo(xw.x), bf_hi(xw.x), bf_lo(xw.y), bf_hi(xw.y)}; x += sum * sc;
        u32x2 w; w.x = cvt_pk_bf16(x[0], x[1]); w.y = cvt_pk_bf16(x[2], x[3]); *(u32x2*)(XB + off) = w;
        float ss = (x[0] * x[0] + x[1] * x[1]) + (x[2] * x[2] + x[3] * x[3]);
        ss += __shfl_xor(ss, 1); ss += __shfl_xor(ss, 2); ss += __shfl_xor(ss, 4); ss += __shfl_xor(ss, 8); ss += __shfl_xor(ss, 16);
        if ((tid & 31) == 0) SS[(size_t)(row0 + row) * 16 + ct] = ss;
    } else {
        float sm = 0.f;
#pragma unroll
        for (int q = 0; q < 4; ++q) sm += (sv[q][0] + sv[q][1]) + (sv[q][2] + sv[q][3]);
        const float rs = __builtin_amdgcn_rsqf(sm * (1.0f / 1024.0f) + EPS) * sc;
        u32x2 w; w.x = cvt_pk_bf16(sum[0] * rs, sum[1] * rs); w.y = cvt_pk_bf16(sum[2] * rs, sum[3] * rs); *(u32x2*)(OUT + off) = w;
    }
    __syncthreads();
}

__device__ __forceinline__ void small_gemm_res(LAS unsigned char* lds, const bf16_t* A, const bf16_t* Bt, int K, int unit, bf16_t* XB, float* SS, float sc) {
    int tid = threadIdx.x; asm volatile("" : "+v"(tid));
    const int wave = __builtin_amdgcn_readfirstlane(tid >> 6), lane = tid & 63, li = lane & 15, g4 = lane >> 4;
    const int ux = unit & 7, ur = unit >> 3;
    const int ct = 2 * ux + (ur & 1), rt = ur >> 1, row0 = TP + 32 * rt, col0 = 64 * ct;
    const int KS = K >> 8;
    const int row = tid >> 4, c4 = (tid & 15) * 4;
    const size_t off = (size_t)(row0 + row) * D + col0 + c4;
    const u32x2 xw = *(const u32x2*)(XB + off);
    f32x4 acc[2][4];
#pragma unroll
    for (int m = 0; m < 2; ++m)
#pragma unroll
        for (int t = 0; t < 4; ++t) acc[m][t] = (f32x4){0.f, 0.f, 0.f, 0.f};
    const bf16_t* ap = A + (size_t)(row0 + li) * K + 8 * g4 + 32 * wave * KS;
    const bf16_t* bp = Bt + (size_t)(col0 + li) * K + 8 * g4 + 32 * wave * KS;
#pragma unroll 6
    for (int ks = 0; ks < KS; ++ks) {
        const bf16x8 a0 = *(const bf16x8*)(ap + 32 * ks), a1 = *(const bf16x8*)(ap + (size_t)16 * K + 32 * ks);
#pragma unroll
        for (int t = 0; t < 4; ++t) { const bf16x8 b = *(const bf16x8*)(bp + (size_t)16 * t * K + 32 * ks);
            acc[0][t] = __builtin_amdgcn_mfma_f32_16x16x32_bf16(b, a0, acc[0][t], 0, 0, 0); acc[1][t] = __builtin_amdgcn_mfma_f32_16x16x32_bf16(b, a1, acc[1][t], 0, 0, 0); }
    }
    LAS float* red = (LAS float*)lds;
#pragma unroll
    for (int m = 0; m < 2; ++m)
#pragma unroll
        for (int t = 0; t < 4; ++t) *(LAS f32x4*)(red + (wave * 32 + 16 * m + li) * 64 + 16 * t + 4 * g4) = acc[m][t];
    __syncthreads();
    f32x4 sum = *(LAS f32x4*)(red + row * 64 + c4);
#pragma unroll
    for (int w = 1; w < 8; ++w) sum += *(LAS f32x4*)(red + (w * 32 + row) * 64 + c4);
    f32x4 x = (f32x4){bf_lo(xw.x), bf_hi(xw.x), bf_lo(xw.y), bf_hi(xw.y)}; x += sum * sc;
    u32x2 w; w.x = cvt_pk_bf16(x[0], x[1]); w.y = cvt_pk_bf16(x[2], x[3]); *(u32x2*)(XB + off) = w;
    float ss = (x[0] * x[0] + x[1] * x[1]) + (x[2] * x[2] + x[3] * x[3]);
    ss += __shfl_xor(ss, 1); ss += __shfl_xor(ss, 2); ss += __shfl_xor(ss, 4); ss += __shfl_xor(ss, 8);
    if ((tid & 15) == 0) SS[(size_t)(row0 + row) * 16 + ct] = ss;
    __syncthreads();
}

__device__ __forceinline__ void small_gemm_q256(LAS unsigned char* lds, const bf16_t* A, const bf16_t* Bt, int unit, const float* SS, float sc, bf16_t* OUT) {
    int tid = threadIdx.x; asm volatile("" : "+v"(tid));
    const int wave = __builtin_amdgcn_readfirstlane(tid >> 6), lane = tid & 63, li = lane & 15, g4 = lane >> 4;
    const int rt = unit >> 2, ct = unit & 3, row0 = TP + 16 * rt, col0 = 256 * ct;
    constexpr int K = D, KS = 4;
    const int row = tid >> 5;
    f32x4 sv[4];
#pragma unroll
    for (int q = 0; q < 4; ++q) sv[q] = ((const f32x4*)(SS + (size_t)(row0 + row) * 16))[q];
    f32x4 acc[16];
#pragma unroll
    for (int t = 0; t < 16; ++t) acc[t] = (f32x4){0.f, 0.f, 0.f, 0.f};
    const bf16_t* ap = A + (size_t)(row0 + li) * K + 8 * g4 + 32 * wave * KS;
    const bf16_t* bp = Bt + (size_t)(col0 + li) * K + 8 * g4 + 32 * wave * KS;
#pragma unroll 2
    for (int ks = 0; ks < KS; ++ks) {
        const bf16x8 a = *(const bf16x8*)(ap + 32 * ks);
#pragma unroll
        for (int t = 0; t < 16; ++t) { const bf16x8 b = *(const bf16x8*)(bp + (size_t)16 * t * K + 32 * ks); acc[t] = __builtin_amdgcn_mfma_f32_16x16x32_bf16(b, a, acc[t], 0, 0, 0); }
    }
    LAS float* red = (LAS float*)lds;
#pragma unroll
    for (int t = 0; t < 16; ++t) *(LAS f32x4*)(red + (wave * 16 + li) * 256 + 16 * t + 4 * g4) = acc[t];
    __syncthreads();
    float sm = 0.f;
#pragma unroll
    for (int q = 0; q < 4; ++q) sm += (sv[q][0] + sv[q][1]) + (sv[q][2] + sv[q][3]);
    const float rs = __builtin_amdgcn_rsqf(sm * (1.0f / 1024.0f) + EPS) * sc;
#pragma unroll
    for (int cc = 0; cc < 2; ++cc) {
        const int c4 = (tid & 31) * 4 + 128 * cc;
        f32x4 sum = *(LAS f32x4*)(red + row * 256 + c4);
#pragma unroll
        for (int w = 1; w < 8; ++w) sum += *(LAS f32x4*)(red + (w * 16 + row) * 256 + c4);
        u32x2 w; w.x = cvt_pk_bf16(sum[0] * rs, sum[1] * rs); w.y = cvt_pk_bf16(sum[2] * rs, sum[3] * rs);
        *(u32x2*)(OUT + (size_t)(row0 + row) * D + col0 + c4) = w;
    }
    asm volatile("s_waitcnt vmcnt(0)" ::: "memory");
    __syncthreads();
}

__device__ __forceinline__ void transpose_item(const float* W, int K, int N, const float* gain, bf16_t* WT, int dst_row0, LAS float* scr, int kb, int n0, int lane) {
    const int k0 = 64 * kb, n4 = (lane & 7) * 4, kr = lane >> 3;
    f32x4 v[8]; float g[8];
#pragma unroll
    for (int i = 0; i < 8; ++i) { v[i] = *(const f32x4*)(W + (size_t)(k0 + kr + 8 * i) * N + n0 + n4); g[i] = gain ? gain[k0 + kr + 8 * i] : 1.0f; }
#pragma unroll
    for (int i = 0; i < 8; ++i) { LAS float* d = scr + (kr + 8 * i) * 33 + n4; d[0] = v[i][0] * g[i]; d[1] = v[i][1] * g[i]; d[2] = v[i][2] * g[i]; d[3] = v[i][3] * g[i]; }
    asm volatile("s_waitcnt lgkmcnt(0)" ::: "memory");
    const int c = lane & 7;
#pragma unroll
    for (int j = 0; j < 4; ++j) { const int n = (lane >> 3) + 8 * j; const LAS float* s = scr + (8 * c) * 33 + n;
        u32x4 o; o.x = cvt_pk_bf16(s[0 * 33], s[1 * 33]); o.y = cvt_pk_bf16(s[2 * 33], s[3 * 33]); o.z = cvt_pk_bf16(s[4 * 33], s[5 * 33]); o.w = cvt_pk_bf16(s[6 * 33], s[7 * 33]);
        *(u32x4*)(WT + (size_t)(dst_row0 + n) * K + k0 + 8 * c) = o; }
    asm volatile("s_waitcnt lgkmcnt(0)" ::: "memory");
}

constexpr int WI_UP = 16 * 88, WI_DN = 44 * 32, WI_IN = 16 * 80, WI_SQ = 16 * 32;
constexpr int W_PER_L = 4 * WI_UP + 2 * WI_DN + WI_IN + 5 * WI_SQ, W_NOKV = W_PER_L - 2 * WI_SQ;
__device__ __forceinline__ void weight_item(const Params& P, unsigned char* ws, LAS float* scr, int l, int r, int lane) {
    constexpr int I_UP = WI_UP, I_DN = WI_DN, I_IN = WI_IN, I_SQ = WI_SQ;
        bf16_t* W1a = (bf16_t*)(ws + WS_W1) + (size_t)(2 * l) * 2 * DFF * D; bf16_t* W1b = W1a + (size_t)2 * DFF * D;
        bf16_t* WDa = (bf16_t*)(ws + WS_WD) + (size_t)(2 * l) * D * DFF; bf16_t* WDb = WDa + (size_t)D * DFF;
        const size_t oU = (size_t)l * D * DFF, oS = (size_t)l * D * D;
#define TR_UP(IDX, GIDX, WT, ISUP) { const int kb = r / 88, n0 = (r % 88) * 32; transpose_item(P.in[IDX] + oU, D, DFF, P.in[GIDX] + l * D, WT, (n0 >> 7) * 256 + (n0 & 127) + (ISUP) * 128, scr, kb, n0, lane); return; }
        if (r < I_UP) TR_UP(10, 9, W1a, 0)
        r -= I_UP;
        if (r < I_UP) TR_UP(11, 9, W1a, 1)
        r -= I_UP;
        if (r < I_UP) TR_UP(28, 27, W1b, 0)
        r -= I_UP;
        if (r < I_UP) TR_UP(29, 27, W1b, 1)
        r -= I_UP;
#undef TR_UP
        if (r < I_DN) { const int kb = r / 32, n0 = (r % 32) * 32; transpose_item(P.in[12] + oU, DFF, D, nullptr, WDa, n0, scr, kb, n0, lane); return; }
        r -= I_DN;
        if (r < I_DN) { const int kb = r / 32, n0 = (r % 32) * 32; transpose_item(P.in[30] + oU, DFF, D, nullptr, WDb, n0, scr, kb, n0, lane); return; }
        r -= I_DN;
        if (r < I_IN) { const int kb = r / 80, n0 = (r % 80) * 32; transpose_item(P.in[14] + (size_t)l * D * DIN, D, DIN, P.in[13] + l * D, (bf16_t*)(ws + WS_WIN) + (size_t)l * DIN * D, n0, scr, kb, n0, lane); return; }
        r -= I_IN;
        {
            const int q = r / I_SQ; r %= I_SQ; const int kb = r / 32, n0 = (r % 32) * 32;
            if (q == 0) transpose_item(P.in[20] + oS, D, D, P.in[19] + l * D, (bf16_t*)(ws + WS_WOUT) + oS, n0, scr, kb, n0, lane);
            else if (q == 1) transpose_item(P.in[23] + oS, D, D, P.in[21] + l * D, (bf16_t*)(ws + WS_WXQ) + oS, n0, scr, kb, n0, lane);
            else if (q == 2) transpose_item(P.in[26] + oS, D, D, nullptr, (bf16_t*)(ws + WS_WXO) + oS, n0, scr, kb, n0, lane);
            else if (q == 3) transpose_item(P.in[24] + oS, D, D, P.in[22] + l * D, (bf16_t*)(ws + WS_WKV), l * 2048 + n0, scr, kb, n0, lane);
            else transpose_item(P.in[25] + oS, D, D, P.in[22] + l * D, (bf16_t*)(ws + WS_WKV), l * 2048 + 1024 + n0, scr, kb, n0, lane);
        }
}
__device__ __forceinline__ void weights_deferred(const Params& P, LAS unsigned char* lds, int l, int part, int nparts) {
    int tid = threadIdx.x; asm volatile("" : "+v"(tid));
    const int lane = tid & 63, wave = __builtin_amdgcn_readfirstlane(tid >> 6);
    LAS float* scr = (LAS float*)(lds + wave * 16384);
    for (int r = part * NW + wave; r < W_NOKV; r += nparts * NW) weight_item(P, P.ws, scr, l, r, lane);
}

__device__ __forceinline__ void cache_convert(const Params& P, int l, int pct0, int pct1, int part, int nparts);
__device__ __forceinline__ void prologue(const Params& P, LAS unsigned char* lds, int G, int vcu) {
    int tid = threadIdx.x; asm volatile("" : "+v"(tid));
    const int lane = tid & 63, wave = __builtin_amdgcn_readfirstlane(tid >> 6);
    LAS float* scr = (LAS float*)(lds + wave * 16384);
    unsigned char* ws = P.ws;
    const int gw = vcu * NW + wave, NGW = G * NW;
    for (int it = gw; it < NL * W_PER_L; it += NGW) weight_item(P, ws, scr, it / W_PER_L, it % W_PER_L, lane);
    float* X = (float*)(ws + WS_X); bf16_t* XB = (bf16_t*)(ws + WS_XB); float* SS = (float*)(ws + WS_SS);
    for (int m = gw; m < T + 512; m += NGW) {
        const bool ismem = m >= T;
        const float* xp0 = P.in[0]; const float* xs0 = P.in[1]; const float* mp0 = P.in[2];
        const float* src = ismem ? mp0 + (size_t)(m - T) * D : (m < TP ? xp0 + (size_t)m * D : xs0 + (size_t)(m - TP) * D);
        f32x4 v[4]; float ss = 0.f;
#pragma unroll
        for (int j = 0; j < 4; ++j) { v[j] = ((const f32x4*)src)[lane + 64 * j]; ss += (v[j][0] * v[j][0] + v[j][1] * v[j][1]) + (v[j][2] * v[j][2] + v[j][3] * v[j][3]); }
        ss = wave_sum(ss);
        bf16_t* xb = ismem ? (bf16_t*)(ws + WS_MEMB) + (size_t)(m - T) * D : XB + (size_t)m * D;
        float* ssp = ismem ? (float*)(ws + WS_SSM) + (size_t)(m - T) * 16 : SS + (size_t)m * 16;
#pragma unroll
        for (int j = 0; j < 4; ++j) {
            u32x2 w; w.x = cvt_pk_bf16(v[j][0], v[j][1]); w.y = cvt_pk_bf16(v[j][2], v[j][3]);
            ((u32x2*)xb)[lane + 64 * j] = w;
        }
        if (lane < 16) ssp[lane] = lane == 0 ? ss : 0.f;
    }
    {
        bf16_t* HZC = (bf16_t*)(ws + WS_HZC); bf16_t* HZP = (bf16_t*)(ws + WS_HZP);
        for (int i = (vcu * NW + wave) * 64 + lane; i < NL * 32 * 2 * 256; i += NGW * 64) HZC[i] = (bf16_t)(cvt_pk_bf16(P.in[5][i], 0.f) & 0xffffu);
        for (int i = (vcu * NW + wave) * 64 + lane; i < NL * 32 * 15 * 256; i += NGW * 64) HZP[i] = (bf16_t)(cvt_pk_bf16(P.in[6][i], 0.f) & 0xffffu);
    }
    bf16_t* PWT = (bf16_t*)(ws + WS_PWT);
    for (int i = (vcu * NW + wave) * 64 + lane; i < NL * 4 * 64 * 64; i += NGW * 64) {
        const int c = i & 63, dout = (i >> 6) & 63, lg = i >> 12;
        const float v = P.in[17][((size_t)lg * 64 + c) * 64 + dout] * P.in[18][lg * 64 + dout];
        PWT[i] = (bf16_t)(cvt_pk_bf16(v, 0.f) & 0xffffu);
    }
}

__device__ __forceinline__ void cache_convert(const Params& P, int l, int pct0, int pct1, int part, int nparts) {
    int tid = threadIdx.x; asm volatile("" : "+v"(tid));
    constexpr unsigned NGL = 32u * 512u * 512u / 8u;
    const unsigned g0 = (unsigned)((unsigned long long)(2u * NGL) * pct0 / 100u), g1 = (unsigned)((unsigned long long)(2u * NGL) * pct1 / 100u);
    const float* ck = P.in[3] + (size_t)l * 32 * 512 * 512; const float* cv = P.in[4] + (size_t)l * 32 * 512 * 512;
    bf16_t* kb = (bf16_t*)(P.ws + WS_KB16) + (size_t)l * 32 * 512 * 512; bf16_t* vb = (bf16_t*)(P.ws + WS_VB16) + (size_t)l * 32 * 512 * 512;
    float* ok = P.out + OFF_KS + (size_t)l * 32 * 512 * 512; float* ov = P.out + OFF_VS + (size_t)l * 32 * 512 * 512;
#pragma unroll 8
    for (unsigned gi = g0 + (unsigned)part * 512u + tid; gi < g1; gi += (unsigned)nparts * 512u) {
        const bool isv = gi >= NGL; const unsigned e = (isv ? gi - NGL : gi) * 8u; const int key = (int)((e >> 9) & 511u);
        const float* src = (isv ? cv : ck) + e;
        const f32x4 k0 = *(const f32x4*)src, k1 = *(const f32x4*)(src + 4);
        *(bf16x8*)((isv ? vb : kb) + e) = pack8v(k0, k1);
        if (key >= 16) { float* d = (isv ? ov : ok) + e - 16 * 512; *(f32x4*)d = k0; *(f32x4*)(d + 4) = k1; }
    }
}

__device__ __forceinline__ int voff_band(int key, int d) { return ((key >> 3) * 2 + (d >> 5)) * 512 + (key & 7) * 64 + (d & 31) * 2; }
__device__ __forceinline__ void store8f(float* p, const float* f) { *(f32x4*)p = (f32x4){f[0], f[1], f[2], f[3]}; *(f32x4*)(p + 4) = (f32x4){f[4], f[5], f[6], f[7]}; }
__device__ __forceinline__ bf16x8 load8f_bf(const float* p) { const f32x4 a = *(const f32x4*)p, b = *(const f32x4*)(p + 4); return pack8v(a, b); }

struct AttnState { f32x16 O[2]; float mrun, lsum; };
__device__ __forceinline__ int koff_band(int row, int chunk) { return row * 128 + ((chunk ^ ((row >> 1) & 7)) << 4); }
__device__ __forceinline__ void attn_score(AttnState& st, bf16x8 (&pf)[2], const bf16x8 (&kf)[4], const bf16x8 (&qf)[4], int j, int qi, bool mask_hi, LAS float* tab, float tconst, int lane);
__device__ __forceinline__ void k_frags(bf16x8 (&kf)[4], const bf16x8 (&kraw)[4], LAS unsigned char* kst, int lane) {
    const int hi = lane >> 5, r = lane & 31;
#pragma unroll
    for (int i = 0; i < 4; ++i) *(LAS bf16x8*)(kst + koff_band((lane >> 3) + 8 * i, lane & 7)) = kraw[i];
#pragma unroll
    for (int d0 = 0; d0 < 4; ++d0) kf[d0] = *(const LAS bf16x8*)(kst + koff_band(r, 2 * d0 + hi));
}
__device__ __forceinline__ void attn_qk(AttnState& st, bf16x8 (&pf)[2], const bf16x8 (&kraw)[4], const bf16x8 (&qf)[4], int j, int qi, bool mask_hi,
                                        LAS float* tab, float tconst, LAS unsigned char* kst, int lane) {
    bf16x8 kf[4];
    k_frags(kf, kraw, kst, lane);
    attn_score(st, pf, kf, qf, j, qi, mask_hi, tab, tconst, lane);
}
__device__ __forceinline__ void attn_score(AttnState& st, bf16x8 (&pf)[2], const bf16x8 (&kf)[4], const bf16x8 (&qf)[4], int j, int qi, bool mask_hi,
                                           LAS float* tab, float tconst, int lane) {
    constexpr float C2 = 0.125f * LOG2E;
    const int hi = lane >> 5;
    f32x16 s;
#pragma unroll
    for (int e = 0; e < 16; ++e) s[e] = 0.f;
#pragma unroll
    for (int d0 = 0; d0 < 4; ++d0) s = __builtin_amdgcn_mfma_f32_32x32x16_bf16(kf[d0], qf[d0], s, 0, 0, 0);
    if (j >= 12) {
        const int base = 512 + qi - 32 * j - 4 * hi;
#pragma unroll
        for (int e = 0; e < 16; ++e) { int rel = base - ((e & 3) + 8 * (e >> 2)); rel = rel < 128 ? rel : 128; s[e] = s[e] * C2 + tab[rel + 128]; }
    } else {
#pragma unroll
        for (int e = 0; e < 16; ++e) s[e] = s[e] * C2 + tconst;
    }
    if (mask_hi) {
#pragma unroll
        for (int e = 8; e < 16; ++e) s[e] = -1e30f;
    }
    float mx = s[0];
#pragma unroll
    for (int e = 1; e < 16; ++e) mx = fmaxf(mx, s[e]);
    mx = fmaxf(mx, __shfl_xor(mx, 32));
    if (__any(mx > st.mrun + 8.0f)) {
        const float mnew = fmaxf(st.mrun, mx);
        const float alpha = __builtin_amdgcn_exp2f(st.mrun - mnew);
        st.mrun = mnew; st.lsum *= alpha;
#pragma unroll
        for (int db = 0; db < 2; ++db)
#pragma unroll
            for (int e = 0; e < 16; ++e) st.O[db][e] *= alpha;
    }
    float ps = 0.f;
#pragma unroll
    for (int e = 0; e < 16; ++e) { s[e] = __builtin_amdgcn_exp2f(s[e] - st.mrun); ps += s[e]; }
    st.lsum += ps;
#pragma unroll
    for (int s2 = 0; s2 < 2; ++s2) { u32x4 w; w.x = cvt_pk_bf16(s[8 * s2 + 0], s[8 * s2 + 1]); w.y = cvt_pk_bf16(s[8 * s2 + 2], s[8 * s2 + 3]); w.z = cvt_pk_bf16(s[8 * s2 + 4], s[8 * s2 + 5]); w.w = cvt_pk_bf16(s[8 * s2 + 6], s[8 * s2 + 7]);
        pf[s2] = __builtin_bit_cast(bf16x8, w); }
}
__device__ __forceinline__ void attn_pv(AttnState& st, const bf16x8 (&pf)[2], const bf16x8 (&vv)[4], LAS unsigned char* vst, int lane) {
    const int hi = lane >> 5;
#pragma unroll
    for (int i = 0; i < 4; ++i) { const int vr = (lane >> 3) + 8 * i, ch = lane & 7; *(LAS bf16x8*)(vst + voff_band(vr, 8 * ch)) = vv[i]; }
    const int trow = 4 * hi + ((lane & 15) >> 2), tcol = 16 * ((lane >> 4) & 1) + 4 * (lane & 3);
#pragma unroll
    for (int db = 0; db < 2; ++db)
#pragma unroll
        for (int s2 = 0; s2 < 2; ++s2) {
            const s16x4 a0 = tr_read(vst + voff_band(16 * s2 + trow, 32 * db + tcol));
            const s16x4 a1 = tr_read(vst + voff_band(16 * s2 + 8 + trow, 32 * db + tcol));
            const bf16x8 vf = (bf16x8){a0[0], a0[1], a0[2], a0[3], a1[0], a1[1], a1[2], a1[3]};
            st.O[db] = __builtin_amdgcn_mfma_f32_32x32x16_bf16(vf, pf[s2], st.O[db], 0, 0, 0);
        }
}

template <bool SAMPLE>
__device__ __forceinline__ void band_attn(const Params& P, int l, int b, int c, int h, int qb0, int jlo, int jhi, LAS unsigned char* wl, int lane_) {
    int lane = lane_; asm volatile("" : "+v"(lane));
    const int r = lane & 31, hi = lane >> 5;
    LAS float* tab = (LAS float*)wl;
    LAS unsigned char* vst = wl + 2048;
    LAS unsigned char* kst = wl + 6144;
    const bf16_t* Z = (const bf16_t*)(P.ws + WS_Z);
    bf16_t* MIX = (bf16_t*)(P.ws + WS_MIX);
    const float* rb = P.in[15] + (size_t)(l * 8 + h) * 257;
    for (int i = lane; i < 257; i += 64) tab[i] = rb[i] * LOG2E;
    const int qrow0 = SAMPLE ? (TP + b * 16) : (b * SEQ + c * 64);
    const int qi = SAMPLE ? (r & 15) : (32 * qb0 + r);
    bf16x8 qf[4];
#pragma unroll
    for (int d0 = 0; d0 < 4; ++d0) qf[d0] = *(const bf16x8*)(Z + (size_t)(qrow0 + qi) * DIN + h * 64 + 16 * d0 + 8 * hi);
    AttnState st; st.mrun = -1e30f; st.lsum = 0.f;
#pragma unroll
    for (int db = 0; db < 2; ++db)
#pragma unroll
        for (int e = 0; e < 16; ++e) st.O[db][e] = 0.f;
    const float tconst = tab[256];
    const int vr0 = lane >> 3, vch = lane & 7;
    const int NB = jhi;
    const int jb0 = SAMPLE ? jlo : (c < 8 ? (8 - c) * 2 : 0);
    const int krow0 = b * SEQ + (c - 8) * 64;
    const size_t cb = (size_t)(l * 32 + b) * 512;
    const bf16_t* KB = (const bf16_t*)(P.ws + WS_KB16); const bf16_t* VB = (const bf16_t*)(P.ws + WS_VB16);
#define KPTR(j, i) (SAMPLE ? ((j) < 16 ? KB + ((cb + 32 * (j) + vr0 + 8 * (i)) * 8 + h) * 64 + 8 * vch : Z + (size_t)(qrow0 + ((vr0 + 8 * (i)) & 15)) * DIN + 512 + h * 64 + 8 * vch) \
                           : Z + (size_t)(krow0 + 32 * (j) + vr0 + 8 * (i)) * DIN + 512 + h * 64 + 8 * vch)
#define VPTR(j, i) (SAMPLE ? ((j) < 16 ? VB + ((cb + 32 * (j) + vr0 + 8 * (i)) * 8 + h) * 64 + 8 * vch : Z + (size_t)(qrow0 + ((vr0 + 8 * (i)) & 15)) * DIN + 1024 + h * 64 + 8 * vch) \
                           : Z + (size_t)(krow0 + 32 * (j) + vr0 + 8 * (i)) * DIN + 1024 + h * 64 + 8 * vch)
    bf16x8 kc[4], kn[4], kn2[4], vc[4], vn[4];
    {
#pragma unroll
      for (int i = 0; i < 4; ++i) kc[i] = *(const bf16x8*)(KPTR(jb0, i));
#pragma unroll
      for (int i = 0; i < 4; ++i) vc[i] = *(const bf16x8*)(VPTR(jb0, i));
#pragma unroll
      for (int i = 0; i < 4; ++i) kn[i] = *(const bf16x8*)(KPTR(jb0 + 1, i)); }
    for (int j = jb0; j < NB; ++j) {
        if (j + 2 < NB) {
#pragma unroll
            for (int i = 0; i < 4; ++i) kn2[i] = *(const bf16x8*)(KPTR(j + 2, i)); }
        if (j + 1 < NB) {
#pragma unroll
            for (int i = 0; i < 4; ++i) vn[i] = *(const bf16x8*)(VPTR(j + 1, i)); }
        bf16x8 pf[2];
        attn_qk(st, pf, kc, qf, j, qi, SAMPLE && j == 16, tab, tconst, kst, lane);
        if (!SAMPLE) {
            if (c >= 120 && j >= 16 && qb0 == 0) {
                const size_t ob = (size_t)((l * 2 + b) * 512 + (c - 120) * 64 + 32 * (j - 16));
#pragma unroll
                for (int i = 0; i < 4; ++i) { float f[8]; unpack8(vc[i], f); store8f(P.out + OFF_VP + ((ob + vr0 + 8 * i) * 8 + h) * 64 + 8 * vch, f); }
#pragma unroll
                for (int i = 0; i < 4; ++i) { float f[8]; unpack8(kc[i], f); store8f(P.out + OFF_KP + ((ob + vr0 + 8 * i) * 8 + h) * 64 + 8 * vch, f); }
            }
        } else {
            if (j == 16) {
#pragma unroll
                for (int i = 0; i < 2; ++i) { float f[8]; unpack8(kc[i], f); store8f(P.out + OFF_KS + ((cb + 496 + vr0 + 8 * i) * 8 + h) * 64 + 8 * vch, f);
                    unpack8(vc[i], f); store8f(P.out + OFF_VS + ((cb + 496 + vr0 + 8 * i) * 8 + h) * 64 + 8 * vch, f); }
            }
        }
        attn_pv(st, pf, vc, vst, lane);
#pragma unroll
        for (int d0 = 0; d0 < 4; ++d0) { kc[d0] = kn[d0]; kn[d0] = kn2[d0]; vc[d0] = vn[d0]; }
    }
#undef KPTR
#undef VPTR
    float ls = st.lsum; ls += __shfl_xor(ls, 32);
    if (SAMPLE) {
        LAS float* op = (LAS float*)(wl + 10240); LAS float* ml = (LAS float*)(wl + 14336);
        if (r < 16) {
#pragma unroll
            for (int db = 0; db < 2; ++db)
#pragma unroll
                for (int e = 0; e < 16; ++e) op[(32 * db + (e & 3) + 8 * (e >> 2) + 4 * hi) * 16 + r] = st.O[db][e];
            if (hi == 0) { ml[2 * r] = st.mrun; ml[2 * r + 1] = ls; }
        }
        return;
    }
    const float inv = 1.0f / ls;
    float ssq = 0.f;
#pragma unroll
    for (int db = 0; db < 2; ++db)
#pragma unroll
        for (int e = 0; e < 16; ++e) { st.O[db][e] *= inv; ssq += st.O[db][e] * st.O[db][e]; }
    ssq += __shfl_xor(ssq, 32);
    const float rn = __builtin_amdgcn_rsqf(ssq * (1.0f / 64.0f) + EPS);
    if (!SAMPLE || r < 16) {
        bf16_t* op = MIX + (size_t)(qrow0 + qi) * D + h * 64 + 4 * hi;
#pragma unroll
        for (int db = 0; db < 2; ++db)
#pragma unroll
            for (int g4 = 0; g4 < 4; ++g4) { u32x2 w; w.x = cvt_pk_bf16(st.O[db][4 * g4] * rn, st.O[db][4 * g4 + 1] * rn); w.y = cvt_pk_bf16(st.O[db][4 * g4 + 2] * rn, st.O[db][4 * g4 + 3] * rn);
                *(u32x2*)(op + 32 * db + 8 * g4) = w; }
    }
}

__device__ __forceinline__ void band_attn_p2(const Params& P, int l, int b, int c, int h, LAS unsigned char* wl, int lane_) {
    int lane = lane_; asm volatile("" : "+v"(lane));
    const int r = lane & 31, hi = lane >> 5;
    LAS float* tab = (LAS float*)wl;
    LAS unsigned char* vst = wl + 2048;
    LAS unsigned char* kst = wl + 6144;
    const bf16_t* Z = (const bf16_t*)(P.ws + WS_Z);
    bf16_t* MIX = (bf16_t*)(P.ws + WS_MIX);
    const float* rb = P.in[15] + (size_t)(l * 8 + h) * 257;
    for (int i = lane; i < 257; i += 64) tab[i] = rb[i] * LOG2E;
    const int qrow0 = b * SEQ + c * 64;
    bf16x8 qf[2][4];
    AttnState st[2];
#pragma unroll
    for (int qb = 0; qb < 2; ++qb) {
#pragma unroll
        for (int d0 = 0; d0 < 4; ++d0) qf[qb][d0] = *(const bf16x8*)(Z + (size_t)(qrow0 + 32 * qb + r) * DIN + h * 64 + 16 * d0 + 8 * hi);
        st[qb].mrun = -1e30f; st[qb].lsum = 0.f;
#pragma unroll
        for (int db = 0; db < 2; ++db)
#pragma unroll
            for (int e = 0; e < 16; ++e) st[qb].O[db][e] = 0.f;
    }
    const float tconst = tab[256];
    const int vr0 = lane >> 3, vch = lane & 7;
    const int jb0 = c < 8 ? (8 - c) * 2 : 0;
    const bf16_t* zb = Z + (size_t)(b * SEQ + (c - 8) * 64 + vr0) * DIN + h * 64 + 8 * vch;
    bf16x8 kc[4], kn[4], vc[4];
#pragma unroll
    for (int i = 0; i < 4; ++i) kc[i] = *(const bf16x8*)(zb + (size_t)(32 * jb0 + 8 * i) * DIN + 512);
    for (int j = jb0; j < 18; ++j) {
#pragma unroll
        for (int i = 0; i < 4; ++i) vc[i] = *(const bf16x8*)(zb + (size_t)(32 * j + 8 * i) * DIN + 1024);
        if (j + 1 < 18) {
#pragma unroll
            for (int i = 0; i < 4; ++i) kn[i] = *(const bf16x8*)(zb + (size_t)(32 * (j + 1) + 8 * i) * DIN + 512);
        }
        bf16x8 kf[4], pf[2][2];
        k_frags(kf, kc, kst, lane);
#pragma unroll
        for (int qb = 0; qb < 2; ++qb) attn_score(st[qb], pf[qb], kf, qf[qb], j, 32 * qb + r, false, tab, tconst, lane);
#pragma unroll
        for (int i = 0; i < 4; ++i) *(LAS bf16x8*)(vst + voff_band(vr0 + 8 * i, 8 * vch)) = vc[i];
        const int trow = 4 * hi + ((lane & 15) >> 2), tcol = 16 * ((lane >> 4) & 1) + 4 * (lane & 3);
#pragma unroll
        for (int db = 0; db < 2; ++db)
#pragma unroll
            for (int s2 = 0; s2 < 2; ++s2) {
                const s16x4 a0 = tr_read(vst + voff_band(16 * s2 + trow, 32 * db + tcol));
                const s16x4 a1 = tr_read(vst + voff_band(16 * s2 + 8 + trow, 32 * db + tcol));
                const bf16x8 vf = (bf16x8){a0[0], a0[1], a0[2], a0[3], a1[0], a1[1], a1[2], a1[3]};
#pragma unroll
                for (int qb = 0; qb < 2; ++qb) st[qb].O[db] = __builtin_amdgcn_mfma_f32_32x32x16_bf16(vf, pf[qb][s2], st[qb].O[db], 0, 0, 0);
            }
#pragma unroll
        for (int i = 0; i < 4; ++i) kc[i] = kn[i];
    }
    if (c >= 120) {
        const size_t ob = (size_t)((l * 2 + b) * 512 + (c - 120) * 64);
        for (int i = 0; i < 8; ++i) { const int row = vr0 + 8 * i; float f[8];
            unpack8(*(const bf16x8*)(Z + (size_t)(qrow0 + row) * DIN + 512 + h * 64 + 8 * vch), f); store8f(P.out + OFF_KP + ((ob + row) * 8 + h) * 64 + 8 * vch, f);
            unpack8(*(const bf16x8*)(Z + (size_t)(qrow0 + row) * DIN + 1024 + h * 64 + 8 * vch), f); store8f(P.out + OFF_VP + ((ob + row) * 8 + h) * 64 + 8 * vch, f); }
    }
#pragma unroll
    for (int qb = 0; qb < 2; ++qb) {
        float ls = st[qb].lsum; ls += __shfl_xor(ls, 32);
        const float inv = 1.0f / ls;
        float ssq = 0.f;
#pragma unroll
        for (int db = 0; db < 2; ++db)
#pragma unroll
            for (int e = 0; e < 16; ++e) { st[qb].O[db][e] *= inv; ssq += st[qb].O[db][e] * st[qb].O[db][e]; }
        ssq += __shfl_xor(ssq, 32);
        const float rn = __builtin_amdgcn_rsqf(ssq * (1.0f / 64.0f) + EPS);
        bf16_t* op = MIX + (size_t)(qrow0 + 32 * qb + r) * D + h * 64 + 4 * hi;
#pragma unroll
        for (int db = 0; db < 2; ++db)
#pragma unroll
            for (int g4 = 0; g4 < 4; ++g4) { u32x2 w; w.x = cvt_pk_bf16(st[qb].O[db][4 * g4] * rn, st[qb].O[db][4 * g4 + 1] * rn); w.y = cvt_pk_bf16(st[qb].O[db][4 * g4 + 2] * rn, st[qb].O[db][4 * g4 + 3] * rn);
                *(u32x2*)(op + 32 * db + 8 * g4) = w; }
    }
}

__device__ __forceinline__ void sample_merge(const Params& P, int b, int h, LAS unsigned char* lds, int lane_) {
    int lane = lane_; asm volatile("" : "+v"(lane));
    bf16_t* MIX = (bf16_t*)(P.ws + WS_MIX);
    const int q = lane & 15, dq = lane >> 4;
    float mw[8], M = -1e30f;
#pragma unroll
    for (int w = 0; w < 8; ++w) { mw[w] = ((const LAS float*)(lds + w * 16384 + 14336))[2 * q]; M = fmaxf(M, mw[w]); }
    float L = 0.f, o[16];
#pragma unroll
    for (int e = 0; e < 16; ++e) o[e] = 0.f;
#pragma unroll
    for (int w = 0; w < 8; ++w) { const float sc = __builtin_amdgcn_exp2f(mw[w] - M); L += ((const LAS float*)(lds + w * 16384 + 14336))[2 * q + 1] * sc;
        const LAS float* op = (const LAS float*)(lds + w * 16384 + 10240);
#pragma unroll
        for (int e = 0; e < 16; ++e) o[e] += op[(16 * dq + e) * 16 + q] * sc; }
    const float inv = 1.0f / L; float ssq = 0.f;
#pragma unroll
    for (int e = 0; e < 16; ++e) { o[e] *= inv; ssq += o[e] * o[e]; }
    ssq += __shfl_xor(ssq, 16); ssq += __shfl_xor(ssq, 32);
    const float rn = __builtin_amdgcn_rsqf(ssq * (1.0f / 64.0f) + EPS);
#pragma unroll
    for (int e = 0; e < 16; ++e) o[e] *= rn;
    bf16_t* dst = MIX + (size_t)(TP + b * 16 + q) * D + h * 64 + 16 * dq;
    *(bf16x8*)dst = pack8(o); *(bf16x8*)(dst + 8) = pack8(o + 8);
}

template <bool SAMPLE>
__device__ __forceinline__ void conv_part(const Params& P, int l, int b, int c, int tid2_, int it_begin, int it_end, int nthr) {
    int tid2 = tid2_; asm volatile("" : "+v"(tid2));
    const bf16_t* Z = (const bf16_t*)(P.ws + WS_Z);
    bf16_t* MIX = (bf16_t*)(P.ws + WS_MIX);
    const bf16_t* HZC = (const bf16_t*)(P.ws + WS_HZC) + (size_t)(l * 32 + b) * 2 * 256;
    const int row0 = SAMPLE ? (TP + b * 16) : (b * SEQ + c * 64);
    const float* cw = P.in[16] + (size_t)l * 3 * 256;
#pragma unroll 2
    for (int it = it_begin + tid2; it < it_end; it += nthr) {
        const int o = it & 31, i = it >> 5, ch = 8 * o;
        const int tpos = SAMPLE ? i : (c * 64 + i);
        const bf16_t* zr = Z + (size_t)(row0 + i) * DIN;
        float bg[8], u[3][8];
        unpack8(*(const bf16x8*)(zr + 1536 + ch), bg);
#pragma unroll
        for (int k = 0; k < 3; ++k) {
            const bool ok = tpos - k >= 0;
            const bf16_t* zp = zr - (size_t)(ok ? k : 0) * DIN;
            float cg[8], hc[8]; unpack8(*(const bf16x8*)(zp + 1792 + ch), cg); unpack8(*(const bf16x8*)(zp + 2048 + ch), hc);
            float hz[8];
            if (SAMPLE) unpack8(*(const bf16x8*)(HZC + (ok ? 0 : (2 + tpos - k)) * 256 + ch), hz);
#pragma unroll
            for (int e = 0; e < 8; ++e) u[2 - k][e] = ok ? cg[e] * hc[e] : (SAMPLE ? hz[e] : 0.f);
        }
        float y[8], ssq = 0.f;
#pragma unroll
        for (int e = 0; e < 8; ++e) { y[e] = bg[e] * (cw[ch + e] * u[0][e] + cw[256 + ch + e] * u[1][e] + cw[512 + ch + e] * u[2][e]); ssq += y[e] * y[e]; }
        ssq += __shfl_xor(ssq, 1); ssq += __shfl_xor(ssq, 2); ssq += __shfl_xor(ssq, 4);
        const float rn = __builtin_amdgcn_rsqf(ssq * (1.0f / 64.0f) + EPS);
#pragma unroll
        for (int e = 0; e < 8; ++e) y[e] *= rn;
        *(bf16x8*)(MIX + (size_t)(row0 + i) * D + 512 + ch) = pack8(y);
        if (SAMPLE) { if (i >= 14) store8f(P.out + OFF_CS + ((size_t)(l * 32 + b) * 2 + (i - 14)) * 256 + ch, u[2]); }
        else { if (tpos >= SEQ - 2) store8f(P.out + OFF_CP + ((size_t)(l * 2 + b) * 2 + (tpos - (SEQ - 2))) * 256 + ch, u[2]); }
    }
}

template <bool SAMPLE, int GG>
__device__ __forceinline__ void pool_task(const Params& P, int l, int b, int c, int tb, int lane_) {
    int lane = lane_; asm volatile("" : "+v"(lane));
    constexpr int W = 2 << GG;
    const bf16_t* Z = (const bf16_t*)(P.ws + WS_Z);
    bf16_t* MIX = (bf16_t*)(P.ws + WS_MIX);
    const bf16_t* PW = (const bf16_t*)(P.ws + WS_PWT) + (size_t)(l * 4 + GG) * 4096;
    const bf16_t* HZP = (const bf16_t*)(P.ws + WS_HZP) + (size_t)(l * 32 + b) * 15 * 256 + GG * 64;
    const int r = lane & 31, hi = lane >> 5;
    const int row0 = SAMPLE ? (TP + b * 16) : (b * SEQ + c * 64);
    const int i = SAMPLE ? (r & 15) : (32 * tb + r);
    const int tpos = SAMPLE ? i : (c * 64 + i);
    const bf16_t* zr = Z + (size_t)(row0 + i) * DIN + 2304 + GG * 64 + 8 * hi;
    const float rc = 1.0f / (float)(SAMPLE ? W : (tpos + 1 < W ? tpos + 1 : W));
    bf16x8 pf[4];
#pragma unroll
    for (int ks = 0; ks < 4; ++ks) {
        bf16x8 v[W];
#pragma unroll
        for (int k = 0; k < W; ++k) {
            const int tp = tpos - k;
            const bf16_t* p = (tp >= 0) ? (zr - (size_t)k * DIN) : (SAMPLE ? (HZP + (15 + tp) * 256 + 8 * hi) : zr);
            v[k] = *(const bf16x8*)(p + 16 * ks);
        }
        float acc[8], cur[8];
        unpack8(v[0], cur);
#pragma unroll
        for (int e = 0; e < 8; ++e) acc[e] = cur[e];
#pragma unroll
        for (int k = 1; k < W; ++k) { float f[8]; unpack8(v[k], f); const bool use = SAMPLE || (tpos - k >= 0);
#pragma unroll
            for (int e = 0; e < 8; ++e) acc[e] += use ? f[e] : 0.f; }
#pragma unroll
        for (int e = 0; e < 8; ++e) acc[e] = acc[e] * rc - cur[e];
        pf[ks] = pack8(acc);
        if (SAMPLE) { if (r < 16 && i >= 1) store8f(P.out + OFF_PS + ((size_t)(l * 32 + b) * 15 + (i - 1)) * 256 + GG * 64 + 16 * ks + 8 * hi, cur); }
        else { if (tpos >= SEQ - 15) store8f(P.out + OFF_PP + ((size_t)(l * 2 + b) * 15 + (tpos - (SEQ - 15))) * 256 + GG * 64 + 16 * ks + 8 * hi, cur); }
    }
    f32x16 cc[2];
#pragma unroll
    for (int db = 0; db < 2; ++db) {
#pragma unroll
        for (int e = 0; e < 16; ++e) cc[db][e] = 0.f;
#pragma unroll
        for (int ks = 0; ks < 4; ++ks) { const bf16x8 a = *(const bf16x8*)(PW + (size_t)(32 * db + r) * 64 + 16 * ks + 8 * hi); cc[db] = __builtin_amdgcn_mfma_f32_32x32x16_bf16(a, pf[ks], cc[db], 0, 0, 0); }
    }
    float ssq = 0.f;
#pragma unroll
    for (int db = 0; db < 2; ++db)
#pragma unroll
        for (int e = 0; e < 16; ++e) ssq += cc[db][e] * cc[db][e];
    ssq += __shfl_xor(ssq, 32);
    const float rn = __builtin_amdgcn_rsqf(ssq * (1.0f / 64.0f) + EPS);
    if (!SAMPLE || r < 16) {
        bf16_t* op = MIX + (size_t)(row0 + i) * D + 768 + GG * 64 + 4 * hi;
#pragma unroll
        for (int db = 0; db < 2; ++db)
#pragma unroll
            for (int g4 = 0; g4 < 4; ++g4) { u32x2 wv; wv.x = cvt_pk_bf16(cc[db][4 * g4] * rn, cc[db][4 * g4 + 1] * rn); wv.y = cvt_pk_bf16(cc[db][4 * g4 + 2] * rn, cc[db][4 * g4 + 3] * rn);
                *(u32x2*)(op + 32 * db + 8 * g4) = wv; }
    }
}

__device__ __forceinline__ void mixer_phase(const Params& P, int l, LAS unsigned char* lds, int G, int vcu) {
    int tid = threadIdx.x; asm volatile("" : "+v"(tid));
    const int lane = tid & 63, wave = __builtin_amdgcn_readfirstlane(tid >> 6);
    LAS unsigned char* wl = lds + wave * 16384;
    for (int u = vcu; u < 256; u += G) {
        const int b = u >> 7, c = u & 127;
        band_attn_p2(P, l, b, c, wave, wl, lane);
        const int sb = u >> 3, sh = u & 7;
        band_attn<true>(P, l, sb, 0, sh, 0, 2 * wave, wave == 7 ? 17 : 2 * wave + 2, wl, lane);
        if (wave == 0) pool_task<false, 3>(P, l, b, c, 0, lane);
        else if (wave == 1) pool_task<false, 3>(P, l, b, c, 1, lane);
        else if (wave == 2) pool_task<false, 2>(P, l, b, c, 0, lane);
        else if (wave == 3) pool_task<false, 2>(P, l, b, c, 1, lane);
        else if (wave == 4) pool_task<false, 1>(P, l, b, c, 0, lane);
        else if (wave == 5) pool_task<false, 1>(P, l, b, c, 1, lane);
        else if (wave == 6) pool_task<false, 0>(P, l, b, c, 0, lane);
        else pool_task<false, 0>(P, l, b, c, 1, lane);
        { int t2 = threadIdx.x; asm volatile("" : "+v"(t2)); conv_part<false>(P, l, b, c, t2, 0, 2048, 512); }
        __syncthreads();
        if (wave == 0) sample_merge(P, sb, sh, lds, lane);
        else if (wave == 1) { if (sh == 0) pool_task<true, 0>(P, l, sb, 0, 0, lane); else if (sh == 1) pool_task<true, 1>(P, l, sb, 0, 0, lane);
                              else if (sh == 2) pool_task<true, 2>(P, l, sb, 0, 0, lane); else if (sh == 3) pool_task<true, 3>(P, l, sb, 0, 0, lane); }
        else if (wave < 4) { if (sh >= 4) { int t2 = threadIdx.x; asm volatile("" : "+v"(t2)); conv_part<true>(P, l, sb, 0, t2 - 128, (sh - 4) * 128, (sh - 4) * 128 + 128, 128); } }
        __syncthreads();
    }
}

__device__ __forceinline__ int voff_x(int key, int d) { return ((key >> 3) * 8 + (d >> 5)) * 512 + (key & 7) * 64 + (d & 31) * 2; }
__device__ __forceinline__ int koff_x(int mem, int chunk) { return mem * 512 + ((chunk ^ (mem & 15)) << 4); }

__device__ __forceinline__ void xattn_prompt_unit(const Params& P, int l, int qt, int h, LAS unsigned char* lds, int tid_) {
    int tid = tid_; asm volatile("" : "+v"(tid));
    const int lane = tid & 63, wave = __builtin_amdgcn_readfirstlane(tid >> 6), r = lane & 31, hi = lane >> 5;
    const int b = qt >> 5;
    const bf16_t* Q2 = (const bf16_t*)(P.ws + WS_Q2);
    bf16_t* O2 = (bf16_t*)(P.ws + WS_O2);
    const bf16_t* MK = (const bf16_t*)(P.ws + WS_MEMKV) + ((size_t)(2 * l) * 512 + b * 256) * 1024 + h * 256;
    const bf16_t* MV = (const bf16_t*)(P.ws + WS_MEMKV) + ((size_t)(2 * l + 1) * 512 + b * 256) * 1024 + h * 256;
    const int qrow = qt * 256 + wave * 32 + r;
    const int sm0 = tid >> 5, sc0 = tid & 31;
    const unsigned gsrc = (unsigned)(sm0 * 1024 + sc0 * 8);
    bf16x8 stg[2];
    stg[0] = *(const bf16x8*)(MK + gsrc); stg[1] = *(const bf16x8*)(MK + gsrc + 16 * 1024);
    bf16x8 qf[16];
#pragma unroll
    for (int ks = 0; ks < 16; ++ks) qf[ks] = *(const bf16x8*)(Q2 + (size_t)qrow * D + h * 256 + 16 * ks + 8 * hi);
    *(LAS bf16x8*)(lds + koff_x(sm0, sc0)) = stg[0]; *(LAS bf16x8*)(lds + koff_x(sm0 + 16, sc0)) = stg[1];
    __syncthreads();
    f32x16 S[8];
#pragma unroll
    for (int s = 0; s < 8; ++s) {
        LAS unsigned char* cur = lds + (s & 1) * 16384; LAS unsigned char* nxt = lds + ((s + 1) & 1) * 16384;
        const bf16_t* src = (s < 7) ? MK + (size_t)(s + 1) * 32 * 1024 : MV;
        stg[0] = *(const bf16x8*)(src + gsrc); stg[1] = *(const bf16x8*)(src + gsrc + 16 * 1024);
#pragma unroll
        for (int e = 0; e < 16; ++e) S[s][e] = 0.f;
#pragma unroll
        for (int ks = 0; ks < 16; ++ks) { const bf16x8 kf = *(const LAS bf16x8*)(cur + koff_x(r, 2 * ks + hi)); S[s] = __builtin_amdgcn_mfma_f32_32x32x16_bf16(kf, qf[ks], S[s], 0, 0, 0); }
        if (s < 7) { *(LAS bf16x8*)(nxt + koff_x(sm0, sc0)) = stg[0]; *(LAS bf16x8*)(nxt + koff_x(sm0 + 16, sc0)) = stg[1]; }
        else { *(LAS bf16x8*)(nxt + voff_x(sm0, 8 * sc0)) = stg[0]; *(LAS bf16x8*)(nxt + voff_x(sm0 + 16, 8 * sc0)) = stg[1]; }
        __syncthreads();
    }
    float mx = S[0][0];
#pragma unroll
    for (int s = 0; s < 8; ++s)
#pragma unroll
        for (int e = 0; e < 16; ++e) mx = fmaxf(mx, S[s][e]);
    mx = fmaxf(mx, __shfl_xor(mx, 32));
    float lsum = 0.f;
    bf16x8 pf[8][2];
#pragma unroll
    for (int s = 0; s < 8; ++s) {
#pragma unroll
        for (int e = 0; e < 16; ++e) { S[s][e] = __builtin_amdgcn_exp2f(S[s][e] - mx); lsum += S[s][e]; }
#pragma unroll
        for (int s2 = 0; s2 < 2; ++s2) { u32x4 w; w.x = cvt_pk_bf16(S[s][8 * s2 + 0], S[s][8 * s2 + 1]); w.y = cvt_pk_bf16(S[s][8 * s2 + 2], S[s][8 * s2 + 3]); w.z = cvt_pk_bf16(S[s][8 * s2 + 4], S[s][8 * s2 + 5]); w.w = cvt_pk_bf16(S[s][8 * s2 + 6], S[s][8 * s2 + 7]);
            pf[s][s2] = __builtin_bit_cast(bf16x8, w); }
    }
    lsum += __shfl_xor(lsum, 32);
    f32x16 O[8];
#pragma unroll
    for (int db = 0; db < 8; ++db)
#pragma unroll
        for (int e = 0; e < 16; ++e) O[db][e] = 0.f;
    const int trow = 4 * hi + ((lane & 15) >> 2), tcol = 16 * ((lane >> 4) & 1) + 4 * (lane & 3);
#pragma unroll
    for (int s = 8; s < 16; ++s) {
        LAS unsigned char* cur = lds + (s & 1) * 16384; LAS unsigned char* nxt = lds + ((s + 1) & 1) * 16384;
        if (s < 15) { const bf16_t* src = MV + (size_t)(s - 7) * 32 * 1024; stg[0] = *(const bf16x8*)(src + gsrc); stg[1] = *(const bf16x8*)(src + gsrc + 16 * 1024); }
#pragma unroll
        for (int db = 0; db < 8; ++db)
#pragma unroll
            for (int s2 = 0; s2 < 2; ++s2) {
                const s16x4 a0 = tr_read(cur + voff_x(16 * s2 + trow, 32 * db + tcol));
                const s16x4 a1 = tr_read(cur + voff_x(16 * s2 + 8 + trow, 32 * db + tcol));
                const bf16x8 vf = (bf16x8){a0[0], a0[1], a0[2], a0[3], a1[0], a1[1], a1[2], a1[3]};
                O[db] = __builtin_amdgcn_mfma_f32_32x32x16_bf16(vf, pf[s - 8][s2], O[db], 0, 0, 0);
            }
        if (s < 15) { *(LAS bf16x8*)(nxt + voff_x(sm0, 8 * sc0)) = stg[0]; *(LAS bf16x8*)(nxt + voff_x(sm0 + 16, 8 * sc0)) = stg[1]; }
        __syncthreads();
    }
    const float inv = 1.0f / lsum;
    bf16_t* op = O2 + (size_t)qrow * D + h * 256 + 4 * hi;
#pragma unroll
    for (int db = 0; db < 8; ++db)
#pragma unroll
        for (int g4 = 0; g4 < 4; ++g4) { u32x2 w; w.x = cvt_pk_bf16(O[db][4 * g4] * inv, O[db][4 * g4 + 1] * inv); w.y = cvt_pk_bf16(O[db][4 * g4 + 2] * inv, O[db][4 * g4 + 3] * inv);
            *(u32x2*)(op + 32 * db + 8 * g4) = w; }
}

__device__ __forceinline__ void xattn_sample_unit(const Params& P, int l, int b, int h, LAS unsigned char* lds, int tid_) {
    int tid = tid_; asm volatile("" : "+v"(tid));
    const int lane = tid & 63, wave = __builtin_amdgcn_readfirstlane(tid >> 6), r = lane & 31, hi = lane >> 5;
    const bf16_t* Q2 = (const bf16_t*)(P.ws + WS_Q2);
    bf16_t* O2 = (bf16_t*)(P.ws + WS_O2);
    const float* CK = P.in[7] + ((size_t)(l * 32 + b) * 256 + 32 * wave) * 1024 + h * 256;
    const float* CV = P.in[8] + ((size_t)(l * 32 + b) * 256 + 32 * wave) * 1024 + h * 256;
    LAS unsigned char* wl = lds + wave * 16384;
    LAS float* ml = (LAS float*)(lds + 131072);
    const int qrow = TP + b * 16 + (r & 15);
#pragma unroll 4
    for (int i = 0; i < 16; ++i) { const int idx = lane + 64 * i, vr = idx >> 5, ch = idx & 31;
        *(LAS bf16x8*)(wl + voff_x(vr, 8 * ch)) = load8f_bf(CV + (size_t)vr * 1024 + 8 * ch); }
    f32x16 S;
#pragma unroll
    for (int e = 0; e < 16; ++e) S[e] = 0.f;
#pragma unroll 4
    for (int ks = 0; ks < 16; ++ks) {
        const bf16x8 qf = *(const bf16x8*)(Q2 + (size_t)qrow * D + h * 256 + 16 * ks + 8 * hi);
        const bf16x8 kf = load8f_bf(CK + (size_t)r * 1024 + 16 * ks + 8 * hi);
        S = __builtin_amdgcn_mfma_f32_32x32x16_bf16(kf, qf, S, 0, 0, 0);
    }
    float mx = S[0];
#pragma unroll
    for (int e = 1; e < 16; ++e) mx = fmaxf(mx, S[e]);
    mx = fmaxf(mx, __shfl_xor(mx, 32));
    float ls = 0.f;
#pragma unroll
    for (int e = 0; e < 16; ++e) { S[e] = __builtin_amdgcn_exp2f(S[e] - mx); ls += S[e]; }
    ls += __shfl_xor(ls, 32);
    bf16x8 pf[2];
#pragma unroll
    for (int s2 = 0; s2 < 2; ++s2) { u32x4 w; w.x = cvt_pk_bf16(S[8 * s2 + 0], S[8 * s2 + 1]); w.y = cvt_pk_bf16(S[8 * s2 + 2], S[8 * s2 + 3]); w.z = cvt_pk_bf16(S[8 * s2 + 4], S[8 * s2 + 5]); w.w = cvt_pk_bf16(S[8 * s2 + 6], S[8 * s2 + 7]);
        pf[s2] = __builtin_bit_cast(bf16x8, w); }
    f32x16 O[8];
    const int trow = 4 * hi + ((lane & 15) >> 2), tcol = 16 * ((lane >> 4) & 1) + 4 * (lane & 3);
#pragma unroll
    for (int db = 0; db < 8; ++db) {
#pragma unroll
        for (int e = 0; e < 16; ++e) O[db][e] = 0.f;
#pragma unroll
        for (int s2 = 0; s2 < 2; ++s2) {
            const s16x4 a0 = tr_read(wl + voff_x(16 * s2 + trow, 32 * db + tcol));
            const s16x4 a1 = tr_read(wl + voff_x(16 * s2 + 8 + trow, 32 * db + tcol));
            const bf16x8 vf = (bf16x8){a0[0], a0[1], a0[2], a0[3], a1[0], a1[1], a1[2], a1[3]};
            O[db] = __builtin_amdgcn_mfma_f32_32x32x16_bf16(vf, pf[s2], O[db], 0, 0, 0);
        }
    }
    if (lane < 16) { ml[(wave * 16 + lane) * 2] = mx; ml[(wave * 16 + lane) * 2 + 1] = ls; }
    if (r < 16) {
        LAS float* ow = (LAS float*)wl;
#pragma unroll
        for (int db = 0; db < 8; ++db)
#pragma unroll
            for (int e = 0; e < 16; ++e) ow[(32 * db + (e & 3) + 8 * (e >> 2) + 4 * hi) * 16 + r] = O[db][e];
    }
    __syncthreads();
    {
        const int q = tid & 15, dg = tid >> 4;
        float mw[8], M = -1e30f;
#pragma unroll
        for (int w = 0; w < 8; ++w) { mw[w] = ml[(w * 16 + q) * 2]; M = fmaxf(M, mw[w]); }
        float L = 0.f, o[8];
#pragma unroll
        for (int e = 0; e < 8; ++e) o[e] = 0.f;
#pragma unroll
        for (int w = 0; w < 8; ++w) { const float sc = __builtin_amdgcn_exp2f(mw[w] - M); L += ml[(w * 16 + q) * 2 + 1] * sc;
            const LAS float* ow = (const LAS float*)(lds + w * 16384);
#pragma unroll
            for (int e = 0; e < 8; ++e) o[e] += ow[(8 * dg + e) * 16 + q] * sc; }
        const float inv = 1.0f / L;
#pragma unroll
        for (int e = 0; e < 8; ++e) o[e] *= inv;
        *(bf16x8*)(O2 + (size_t)(TP + b * 16 + q) * D + h * 256 + 8 * dg) = pack8(o);
    }
    __syncthreads();
}

__device__ __forceinline__ void xattn_phase(const Params& P, int l, LAS unsigned char* lds, int G, int vcu) {
    for (int u = vcu; u < 256; u += G) { xattn_prompt_unit(P, l, u >> 2, u & 3, lds, threadIdx.x); __syncthreads(); }
    for (int u = vcu; u < 128; u += G) xattn_sample_unit(P, l, u >> 2, u & 3, lds, threadIdx.x);
}

#define XB_TMO      128
#define XB_XCNT(j)  (256  + 64 * (j))
#define XB_XSUB(j)  (1280 + 64 * (j))
#define XB_XGEN(j)  (2304 + 64 * (j))
#define XB_TOP      3328
#define XB_TOPGEN   3392
#define XCD_BAR_WORDS 3456
#define XB_SPIN_CAP (1u << 22)
__device__ __forceinline__ unsigned xb_ld(unsigned* p)              { return __hip_atomic_load(p, __ATOMIC_RELAXED, __HIP_MEMORY_SCOPE_AGENT); }
__device__ __forceinline__ unsigned xb_add(unsigned* p, unsigned v) { return __hip_atomic_fetch_add(p, v, __ATOMIC_RELAXED, __HIP_MEMORY_SCOPE_AGENT); }
__device__ __forceinline__ unsigned xb_xcc_id() { return (unsigned)__builtin_amdgcn_s_getreg((3 << 11) | 20) & 0xFu; }
#define XB_SPIN(cond, bar) do { unsigned _sp = 0; while (cond) { __builtin_amdgcn_s_sleep(1); \
    if ((++_sp & 255u) == 0u) { if (xb_ld(&(bar)[XB_TMO])) break; if (_sp > XB_SPIN_CAP) { atomicAdd(&(bar)[XB_TMO], 1u); break; } } } } while (0)
struct XcdBarrier { unsigned* bar; unsigned x; volatile LAS unsigned* st; };
__device__ __forceinline__ XcdBarrier xcd_barrier_post(unsigned* bar, volatile LAS unsigned* st) {
    XcdBarrier b; b.bar = bar; b.x = xb_xcc_id(); b.st = st;
    if (threadIdx.x == 0) (void)xb_add(&bar[XB_XCNT(b.x)], 1u);
    return b;
}
__device__ __forceinline__ void xcd_barrier_complete(unsigned* bar, unsigned x, unsigned& nloc, unsigned& nx) {
    const unsigned G = gridDim.x * gridDim.y * gridDim.z;
    unsigned sum, cnt, mine, sp = 0u;
    for (;;) {
        sum = 0u; cnt = 0u; mine = 0u;
#pragma unroll
        for (unsigned j = 0; j < 16; ++j) { const unsigned c = xb_ld(&bar[XB_XCNT(j)]); sum += c; cnt += (c > 0u) ? 1u : 0u; mine = (j == x) ? c : mine; }
        if (sum == G) break;
        __builtin_amdgcn_s_sleep(1);
        if ((++sp & 255u) == 0u) { if (xb_ld(&bar[XB_TMO])) break; if (sp > XB_SPIN_CAP) { atomicAdd(&bar[XB_TMO], 1u); break; } }
    }
    nloc = mine > 0u ? mine : 1u; nx = cnt > 0u ? cnt : 1u;
}
__device__ __forceinline__ void xcd_barrier(const XcdBarrier& b) {
    asm volatile("s_waitcnt vmcnt(0)" ::: "memory");
    __syncthreads();
    if (threadIdx.x == 0) {
        unsigned* bar = b.bar; unsigned bx_ = b.x; asm volatile("" : "+s"(bar), "+s"(bx_));
        __builtin_amdgcn_s_waitcnt(0);
        unsigned nloc = b.st[0], nx = b.st[1];
        if (nloc == 0u) { xcd_barrier_complete(bar, bx_, nloc, nx); b.st[0] = nloc; b.st[1] = nx; }
        const unsigned old = xb_add(&bar[XB_XSUB(bx_)], 1u);
        const unsigned gen = old / nloc;
        if (old + 1u == (gen + 1u) * nloc) {
            __builtin_amdgcn_fence(__ATOMIC_RELEASE, "agent");
            asm volatile("s_waitcnt vmcnt(0)" ::: "memory");
            const unsigned og = xb_add(&bar[XB_TOP], 1u);
            const unsigned tg = og / nx;
            if (og + 1u == (tg + 1u) * nx) xb_add(&bar[XB_TOPGEN], 1u);
            else XB_SPIN(xb_ld(&bar[XB_TOPGEN]) == tg, bar);
            __builtin_amdgcn_fence(__ATOMIC_ACQUIRE, "agent");
            xb_add(&bar[XB_XGEN(bx_)], 1u);
            asm volatile("s_waitcnt vmcnt(0)" ::: "memory");
        } else {
            XB_SPIN(xb_ld(&bar[XB_XGEN(bx_)]) == gen, bar);
            __builtin_amdgcn_fence(__ATOMIC_ACQUIRE, "agent");
            asm volatile("s_waitcnt vmcnt(0)" ::: "memory");
        }
    }
    __syncthreads();
}

__global__ void __launch_bounds__(512, 2) mega_fwd(Params P) {
    extern __shared__ __attribute__((aligned(16))) unsigned char lds_raw[];
    LAS unsigned char* lds = (LAS unsigned char*)lds_raw;
    cg::grid_group grid = cg::this_grid();
    const int G = gridDim.x, bx = blockIdx.x;
    const int vcu = (G % 8 == 0) ? (bx % 8) * (G / 8) + bx / 8 : bx;
    unsigned char* ws0 = P.ws;

    volatile LAS unsigned* bst = (volatile LAS unsigned*)(lds + 131072 + 8192);
    if (threadIdx.x < 2) bst[threadIdx.x] = 0u;
    __syncthreads();
    XcdBarrier xbar = xcd_barrier_post((unsigned*)(ws0 + WS_CTL), bst);
    prologue(P, lds, G, vcu);
    if (P.ws == nullptr) grid.sync();
    xcd_barrier(xbar);

    for (int step = 0; step < 36; ++step) {
        const int l = step / 9; int s = step % 9; if (s >= 6) ++s;
        unsigned char* ws = ws0; asm volatile("" : "+s"(ws));
        float* X = (float*)(ws + WS_X); bf16_t* XB = (bf16_t*)(ws + WS_XB); float* SS = (float*)(ws + WS_SS);
        bf16_t* ACT = (bf16_t*)(ws + WS_ACT); bf16_t* Z = (bf16_t*)(ws + WS_Z); bf16_t* MIX = (bf16_t*)(ws + WS_MIX);
        bf16_t* Q2 = (bf16_t*)(ws + WS_Q2); bf16_t* O2 = (bf16_t*)(ws + WS_O2);
        if (s == 0 || s == 8) {
            const int f = 2 * l + (s == 8);
            pg8::Gemm g{XB, (const bf16_t*)(ws + WS_W1) + (size_t)f * 2 * DFF * D, T, 2 * DFF, D};
            pg8::StaticOrder S; S.init(T, 2 * DFF, G, bx);
            pg8::EpiSwiglu E{ACT};
            pg8::gemm_phase(lds, g, S, E, SS);
        }
        if (s == 2 || s == 5 || step == 0) {
            pg8::Gemm g; pg8::StaticOrder S; pg8::EpiScale E; const float* ssp = SS;
            if (step == 0) { ssp = (const float*)(ws + WS_SSM); g = pg8::Gemm{(const bf16_t*)(ws + WS_MEMB), (const bf16_t*)(ws + WS_WKV), 512, 8192, D}; S.init(512, 8192, G, (bx + 64) % G);
                E = pg8::EpiScale{(bf16_t*)(ws + WS_MEMKV), 1024, 1.0f, 1, P.out + OFF_MK}; }
            else if (s == 2) { g = pg8::Gemm{XB, (const bf16_t*)(ws + WS_WIN) + (size_t)l * DIN * D, T, DIN, D}; S.init(T, DIN, G, bx);
                E = pg8::EpiScale{Z, DIN, 1.0f, 0, nullptr}; }
            else { g = pg8::Gemm{XB, (const bf16_t*)(ws + WS_WXQ) + (size_t)l * D * D, TP, D, D}; S.init(TP, D, G, bx);
                E = pg8::EpiScale{Q2, D, 0.0625f * LOG2E, 0, nullptr}; }
            pg8::gemm_phase(lds, g, S, E, ssp);
            if (s == 5) {
                asm volatile("s_waitcnt vmcnt(0)" ::: "memory"); __syncthreads();
                pg8::Unit uq;
                for (int i = 0; S.next(i, uq); ++i) { xattn_prompt_unit(P, l, uq.pm, uq.pn, lds, threadIdx.x); __syncthreads(); }
                for (int u = bx; u < 128; u += G) {
                    small_gemm_q256(lds, g.A, g.Bt, u, SS, 0.0625f * LOG2E, Q2);
                    xattn_sample_unit(P, l, u >> 2, u & 3, lds, threadIdx.x);
                }
            }
        }
        if (s == 1 || s == 9 || s == 4 || s == 7) {
            pg8::Gemm g; float sc = 1.0f;
            if (s == 1 || s == 9) { g = pg8::Gemm{ACT, (const bf16_t*)(ws + WS_WD) + (size_t)(2 * l + (s == 9)) * D * DFF, TP, D, DFF}; sc = 0.5f; }
            else if (s == 4) g = pg8::Gemm{MIX, (const bf16_t*)(ws + WS_WOUT) + (size_t)l * D * D, TP, D, D};
            else g = pg8::Gemm{O2, (const bf16_t*)(ws + WS_WXO) + (size_t)l * D * D, TP, D, D};
            pg8::StaticOrder S; S.init(TP, D, G, bx);
            pg8::EpiResid E{X, XB, SS, sc};
            pg8::gemm_phase(lds, g, S, E, nullptr);
            for (int u = bx; u < 256; u += G) small_gemm_res(lds, g.A, g.Bt, g.K, u, XB, SS, sc);
        }
        if (s == 0 || s == 2 || (s == 8 && l < NL - 1)) {
            const int cl = s == 8 ? l + 1 : l, p0 = s == 8 ? 0 : (s == 0 ? (step == 0 ? 0 : 30) : 60), p1 = s == 8 ? 30 : (s == 0 ? 60 : 100);
            int c0 = s == 2 ? 148 : 172; if (G <= c0) c0 = 0;
            if (bx >= c0) cache_convert(P, cl, p0, p1, bx - c0, G - c0);
        }
#ifndef NO_MIXER
        if (s == 3) mixer_phase(P, l, lds, G, vcu);
#endif
        xcd_barrier(xbar);
    }
    {
        int tid = threadIdx.x; asm volatile("" : "+v"(tid));
        const int lane = tid & 63, wave = tid >> 6;
        const float* X = (const float*)(ws0 + WS_X);
        const float* gf = P.in[31];
        for (int m = vcu * NW + wave; m < T; m += G * NW) {
            const u32x2* xr = (const u32x2*)((const bf16_t*)(ws0 + WS_XB) + (size_t)m * D);
            f32x4 v[4]; float ss = 0.f;
#pragma unroll
            for (int j = 0; j < 4; ++j) { const u32x2 xw = xr[lane + 64 * j]; v[j] = (f32x4){bf_lo(xw.x), bf_hi(xw.x), bf_lo(xw.y), bf_hi(xw.y)}; ss += (v[j][0] * v[j][0] + v[j][1] * v[j][1]) + (v[j][2] * v[j][2] + v[j][3] * v[j][3]); }
            ss = wave_sum(ss);
            const float rs = __builtin_amdgcn_rsqf(ss * (1.0f / 1024.0f) + EPS);
#pragma unroll
            for (int j = 0; j < 4; ++j) { const f32x4 gg = ((const f32x4*)gf)[lane + 64 * j]; ((f32x4*)(P.out + OFF_Y + (size_t)m * D))[lane + 64 * j] = v[j] * rs * gg; }
        }
    }
}

constexpr int LDS_BYTES = 131072 + 8192 + 64;
extern "C" void kernel_launch(void* const* d_in, const int* in_sizes, int n_in, void* d_out, int out_size, void* d_ws, size_t ws_size, hipStream_t stream) {
    static int grid = 0;
    if (grid == 0) {
        if (n_in != 32 || (size_t)out_size != OUT_TOTAL || ws_size < WS_END) { fprintf(stderr, "kernel_launch: unexpected sizes n_in %d out %d ws %zu (need %zu)\n", n_in, out_size, ws_size, (size_t)WS_END); grid = -1; return; }
        int dev = 0, cus = 0, per_cu = 0;
        hipGetDevice(&dev);
        hipDeviceGetAttribute(&cus, hipDeviceAttributeMultiprocessorCount, dev);
        if (hipFuncSetAttribute((const void*)mega_fwd, hipFuncAttributeMaxDynamicSharedMemorySize, LDS_BYTES) != hipSuccess) { fprintf(stderr, "kernel_launch: hipFuncSetAttribute failed\n"); grid = -1; return; }
        if (hipOccupancyMaxActiveBlocksPerMultiprocessor(&per_cu, (const void*)mega_fwd, 512, LDS_BYTES) != hipSuccess || per_cu < 1) { fprintf(stderr, "kernel_launch: occupancy query says %d\n", per_cu); per_cu = 1; }
        (void)hipGetLastError();
        grid = cus;
    }
    if (grid < 0) return;
    if (hipMemsetAsync((char*)d_ws + WS_CTL, 0, 16384, stream) != hipSuccess) { fprintf(stderr, "kernel_launch: memset failed\n"); return; }
    Params p{};
    for (int i = 0; i < 32; ++i) p.in[i] = (const float*)d_in[i];
    p.out = (float*)d_out; p.ws = (unsigned char*)d_ws;
    void* args[] = {&p};
    hipError_t e = hipLaunchCooperativeKernel((const void*)mega_fwd, dim3(grid), dim3(512), args, LDS_BYTES, stream);
    if (e != hipSuccess) fprintf(stderr, "cooperative launch failed: %s (grid %d)\n", hipGetErrorString(e), grid);
}
```

```cpp
#include <hip/hip_runtime.h>
#include <hip/hip_cooperative_groups.h>
#include <cstdio>
#include <cstdint>
namespace cg = cooperative_groups;

#define LAS __attribute__((address_space(3)))
typedef unsigned short bf16_t;
typedef short bf16x8 __attribute__((ext_vector_type(8)));
typedef short s16x4 __attribute__((ext_vector_type(4)));
typedef float f32x4 __attribute__((ext_vector_type(4)));
typedef float f32x16 __attribute__((ext_vector_type(16)));
typedef unsigned u32x4 __attribute__((ext_vector_type(4)));
typedef unsigned u32x2 __attribute__((ext_vector_type(2)));

constexpr int D = 1024, SEQ = 8192, TP = 2 * SEQ, TS = 512, T = TP + TS, DFF = 2816, DIN = 2560, NL = 4;
constexpr int NW = 8;
constexpr float EPS = 1e-6f, LOG2E = 1.4426950408889634f;
constexpr size_t OFF_Y = 0;
constexpr size_t OFF_KP = (size_t)T * D;
constexpr size_t OFF_VP = OFF_KP + (size_t)NL * 2 * 512 * 512;
constexpr size_t OFF_CP = OFF_VP + (size_t)NL * 2 * 512 * 512;
constexpr size_t OFF_PP = OFF_CP + (size_t)NL * 2 * 2 * 256;
constexpr size_t OFF_MK = OFF_PP + (size_t)NL * 2 * 15 * 256;
constexpr size_t OFF_MV = OFF_MK + (size_t)NL * 512 * 1024;
constexpr size_t OFF_KS = OFF_MV + (size_t)NL * 512 * 1024;
constexpr size_t OFF_VS = OFF_KS + (size_t)NL * 32 * 512 * 512;
constexpr size_t OFF_CS = OFF_VS + (size_t)NL * 32 * 512 * 512;
constexpr size_t OFF_PS = OFF_CS + (size_t)NL * 32 * 2 * 256;
constexpr size_t OUT_TOTAL = OFF_PS + (size_t)NL * 32 * 15 * 256;
static_assert(OUT_TOTAL == 93390848, "output size");

constexpr size_t al(size_t x) { return (x + 1048575) & ~(size_t)1048575; }
constexpr size_t WS_X = 0;
constexpr size_t WS_XB = WS_X + al((size_t)T * D * 4);
constexpr size_t WS_SS = WS_XB + al((size_t)T * D * 2);
constexpr size_t WS_ACT = WS_SS + al((size_t)T * 16 * 4);
constexpr size_t WS_Z = WS_ACT + al((size_t)T * DFF * 2);
constexpr size_t WS_MIX = WS_Z + al((size_t)T * DIN * 2);
constexpr size_t WS_Q2 = WS_MIX + al((size_t)T * D * 2);
constexpr size_t WS_O2 = WS_Q2 + al((size_t)T * D * 2);
constexpr size_t WS_MEMB = WS_O2 + al((size_t)T * D * 2);
constexpr size_t WS_SSM = WS_MEMB + al((size_t)512 * D * 2);
constexpr size_t WS_MEMKV = WS_SSM + al((size_t)512 * 16 * 4);
constexpr size_t WS_W1 = WS_MEMKV + al((size_t)8 * 512 * D * 2);
constexpr size_t WS_WD = WS_W1 + al((size_t)8 * 2 * DFF * D * 2);
constexpr size_t WS_WIN = WS_WD + al((size_t)8 * D * DFF * 2);
constexpr size_t WS_WOUT = WS_WIN + al((size_t)NL * DIN * D * 2);
constexpr size_t WS_WXQ = WS_WOUT + al((size_t)NL * D * D * 2);
constexpr size_t WS_WXO = WS_WXQ + al((size_t)NL * D * D * 2);
constexpr size_t WS_WKV = WS_WXO + al((size_t)NL * D * D * 2);
constexpr size_t WS_PWT = WS_WKV + al((size_t)NL * 2 * D * D * 2);
constexpr size_t WS_HZC = WS_PWT + al((size_t)NL * 4 * 64 * 64 * 2);
constexpr size_t WS_HZP = WS_HZC + al((size_t)NL * 32 * 2 * 256 * 2);
constexpr size_t WS_KB16 = WS_HZP + al((size_t)NL * 32 * 15 * 256 * 2);
constexpr size_t WS_VB16 = WS_KB16 + al((size_t)NL * 32 * 512 * 512 * 2);
constexpr size_t WS_CTL = WS_VB16 + al((size_t)NL * 32 * 512 * 512 * 2);
constexpr size_t WS_END = WS_CTL + al(65536);

struct Params {
    const float* in[32];
    float* out;
    unsigned char* ws;
};

__device__ __forceinline__ unsigned cvt_pk_bf16(float lo, float hi) { unsigned r; asm("v_cvt_pk_bf16_f32 %0, %1, %2" : "=v"(r) : "v"(lo), "v"(hi)); return r; }
__device__ __forceinline__ float bf_lo(unsigned w) { return __uint_as_float(w << 16); }
__device__ __forceinline__ float bf_hi(unsigned w) { return __uint_as_float(w & 0xffff0000u); }
__device__ __forceinline__ void unpack8(bf16x8 v, float* f) {
    u32x4 w = __builtin_bit_cast(u32x4, v);
    f[0] = bf_lo(w.x); f[1] = bf_hi(w.x); f[2] = bf_lo(w.y); f[3] = bf_hi(w.y);
    f[4] = bf_lo(w.z); f[5] = bf_hi(w.z); f[6] = bf_lo(w.w); f[7] = bf_hi(w.w);
}
__device__ __forceinline__ bf16x8 pack8(const float* f) {
    u32x4 w; w.x = cvt_pk_bf16(f[0], f[1]); w.y = cvt_pk_bf16(f[2], f[3]); w.z = cvt_pk_bf16(f[4], f[5]); w.w = cvt_pk_bf16(f[6], f[7]);
    return __builtin_bit_cast(bf16x8, w);
}
__device__ __forceinline__ bf16x8 pack8v(f32x4 a, f32x4 b) {
    u32x4 w; w.x = cvt_pk_bf16(a[0], a[1]); w.y = cvt_pk_bf16(a[2], a[3]); w.z = cvt_pk_bf16(b[0], b[1]); w.w = cvt_pk_bf16(b[2], b[3]);
    return __builtin_bit_cast(bf16x8, w);
}
__device__ __forceinline__ float wave_sum(float v) {
#pragma unroll
    for (int o = 1; o < 64; o <<= 1) v += __shfl_xor(v, o);
    return v;
}
__device__ __forceinline__ float row_rstd(const float* SS, int row) {
    const f32x4* p = (const f32x4*)(SS + (size_t)row * 16);
    const f32x4 a = p[0], b = p[1], c = p[2], d = p[3];
    const float s = ((a[0] + a[1]) + (a[2] + a[3])) + ((b[0] + b[1]) + (b[2] + b[3])) + ((c[0] + c[1]) + (c[2] + c[3])) + ((d[0] + d[1]) + (d[2] + d[3]));
    return __builtin_amdgcn_rsqf(s * (1.0f / 1024.0f) + EPS);
}
__device__ __forceinline__ s16x4 tr_read(LAS unsigned char* p) {
    return __builtin_amdgcn_ds_read_tr16_b64_v4i16((LAS s16x4*)p);
}

namespace pg8 {
constexpr int BM = 256, BK = 64, HALF = 128, HTB = HALF * BK * 2, STAGE_BYTES = 8 * HTB, NXCD = 8, WGM = 8;
__host__ __device__ __forceinline__ int lds_byte(int r, int c) { const int st = (r >> 4) * 2 + (c >> 5), rr = r & 15, cc = c & 31, ob = rr * 64 + cc * 2; return st * 1024 + (ob ^ (((ob >> 9) & 1) << 5)); }
__host__ __device__ __forceinline__ void stage_rc(int b, int& R, int& C) { const int st = b / 1024, sb = b % 1024, swz = sb ^ (((sb >> 9) & 1) << 5); R = (st >> 1) * 16 + swz / 64; C = (st & 1) * 32 + (swz % 64) / 2; }
__host__ __device__ __forceinline__ int perm32(int rho) { const int n = rho >> 4, i = rho & 15; return 8 * (i >> 2) + 4 * n + (i & 3); }

struct Unit { int pm, pn; };
struct Gemm { const bf16_t* A; const bf16_t* Bt; int M, N, K; };

struct StaticOrder {
    int nM, nN, nwg, G, c;
    __device__ void init(int M, int N, int G_, int c_) { nM = M / BM; nN = N / BM; nwg = nM * nN; G = G_; c = c_; }
    __device__ bool next(int i, Unit& u) const {
        const long L = (long)i * G + c; if (L >= nwg) return false;
        int wgid = (int)L; { const int q = nwg / NXCD, r = nwg % NXCD, xcd = wgid % NXCD, off = wgid / NXCD; wgid = (xcd < r ? xcd * (q + 1) : r * (q + 1) + (xcd - r) * q) + off; }
        const int nig = WGM * nN, gid = wgid / nig, fm = gid * WGM, gsz = (nM - fm) < WGM ? (nM - fm) : WGM;
        u.pm = fm + ((wgid % nig) % gsz); u.pn = (wgid % nig) / gsz; return true;
    }
};

struct EpiSwiglu {
    bf16_t* O;
    __device__ __forceinline__ void operator()(const f32x4 (&acc)[2][2][4][2], const Unit& u, const LAS float* rsl, int wr, int wc, int fr, int fq) const {
        const int col0 = u.pn * 128 + wc * 32 + 8 * fq;
#pragma unroll
        for (int ai = 0; ai < 2; ++ai)
#pragma unroll
            for (int m = 0; m < 4; ++m) {
                const int rl = ai * HALF + wr * 64 + m * 16 + fr, row = u.pm * BM + rl;
                const float rs = rsl[rl];
                float o[8];
#pragma unroll
                for (int n = 0; n < 2; ++n)
#pragma unroll
                    for (int e = 0; e < 4; ++e) {
                        const float g = acc[ai][0][m][n][e] * rs, up = acc[ai][1][m][n][e] * rs;
                        const float sg = g * __builtin_amdgcn_rcpf(1.0f + __builtin_amdgcn_exp2f(-g * LOG2E));
                        o[n * 4 + e] = sg * up;
                    }
                *(bf16x8*)(O + (size_t)row * DFF + col0) = pack8(o);
            }
    }
};
struct EpiResid {
    float* X; bf16_t* XB; float* SS; float s;
    __device__ __forceinline__ void operator()(const f32x4 (&acc)[2][2][4][2], const Unit& u, const LAS float* rsl, int wr, int wc, int fr, int fq) const {
        bf16_t* base = XB + (size_t)(u.pm * BM + wr * 64 + fr) * D + u.pn * BM + wc * 32 + 8 * fq;
        bf16x8 xin[2][4][2];
#pragma unroll
        for (int ai = 0; ai < 2; ++ai)
#pragma unroll
            for (int m = 0; m < 4; ++m)
#pragma unroll
                for (int bj = 0; bj < 2; ++bj) xin[ai][m][bj] = *(const bf16x8*)(base + (size_t)(ai * HALF + m * 16) * D + bj * HALF);
#pragma unroll
        for (int ai = 0; ai < 2; ++ai)
#pragma unroll
            for (int m = 0; m < 4; ++m) {
                const int row = u.pm * BM + ai * HALF + wr * 64 + m * 16 + fr;
                float ss = 0.f;
#pragma unroll
                for (int bj = 0; bj < 2; ++bj) {
                    float xf[8]; unpack8(xin[ai][m][bj], xf);
                    f32x4 x0 = (f32x4){xf[0], xf[1], xf[2], xf[3]}, x1 = (f32x4){xf[4], xf[5], xf[6], xf[7]};
                    x0 += acc[ai][bj][m][0] * s; x1 += acc[ai][bj][m][1] * s;
                    *(bf16x8*)(base + (size_t)(ai * HALF + m * 16) * D + bj * HALF) = pack8v(x0, x1);
                    ss += (x0[0] * x0[0] + x0[1] * x0[1]) + (x0[2] * x0[2] + x0[3] * x0[3]) + (x1[0] * x1[0] + x1[1] * x1[1]) + (x1[2] * x1[2] + x1[3] * x1[3]);
                }
                ss += __shfl_xor(ss, 16); ss += __shfl_xor(ss, 32);
                if (fq == 0) SS[(size_t)row * 16 + u.pn * 4 + wc] = ss;
            }
    }
};
struct EpiScale {
    bf16_t* O; int ldc; float cs; int mode; float* out32;
    __device__ __forceinline__ void operator()(const f32x4 (&acc)[2][2][4][2], const Unit& u, const LAS float* rsl, int wr, int wc, int fr, int fq) const {
#pragma unroll
        for (int ai = 0; ai < 2; ++ai)
#pragma unroll
            for (int m = 0; m < 4; ++m) {
                const int rl = ai * HALF + wr * 64 + m * 16 + fr, row = u.pm * BM + rl;
                const float rs = rsl[rl] * cs;
#pragma unroll
                for (int bj = 0; bj < 2; ++bj) {
                    const int col = u.pn * BM + bj * HALF + wc * 32 + 8 * fq;
                    const f32x4 v0 = acc[ai][bj][m][0] * rs, v1 = acc[ai][bj][m][1] * rs;
                    if (mode == 0) {
                        *(bf16x8*)(O + (size_t)row * ldc + col) = pack8v(v0, v1);
                    } else {
                        const int t = col >> 10, c = col & 1023;
                        *(bf16x8*)(O + ((size_t)t * 512 + row) * 1024 + c) = pack8v(v0, v1);
                        float* o = out32 + (size_t)(t & 1) * (OFF_MV - OFF_MK) + (size_t)(t >> 1) * (512 * 1024) + (size_t)row * 1024 + c;
                        *(f32x4*)o = v0; *(f32x4*)(o + 4) = v1;
                    }
                }
            }
    }
};

template <class Epi>
__device__ __forceinline__ void gemm_phase(LAS unsigned char* lds, const Gemm g, const StaticOrder& S, const Epi& E, const float* SS) {
    int tid = threadIdx.x; asm volatile("" : "+v"(tid));
    LAS float* rsl = (LAS float*)(lds + STAGE_BYTES);
    const int wid = __builtin_amdgcn_readfirstlane(tid >> 6), lane = tid & 63, wr = wid >> 2, wc = wid & 3, fr = lane & 15, fq = lane >> 4;
    const int K = g.K, nt = K / BK;
    unsigned voffA[2], voffB[2];
#pragma unroll
    for (int i = 0; i < 2; ++i) { int R, C; stage_rc(tid * 16 + i * 8192, R, C); const int Rb = (R & ~31) + perm32(R & 31);
        voffA[i] = (unsigned)(R * K + C) * 2u; voffB[i] = (unsigned)(Rb * K + C) * 2u; }
    const size_t kstep = (size_t)(BK * 2);
    const size_t hstep = (size_t)HALF * K * 2;
    const size_t tstep = 2 * hstep;
    const unsigned ldsw = (unsigned)wid * 1024u;
    const int aoff = lds_byte(wr * 64 + fr, fq * 8), boff = lds_byte(wc * 32 + fr, fq * 8);
#define PG8_SA(b, h) (((b) * 2 + (h)) * HTB)
#define PG8_SB(b, h) ((4 + (b) * 2 + (h)) * HTB)
#define PG8_STAGE(bufoff, gbase, voff) do { _Pragma("unroll") for (int _i = 0; _i < 2; ++_i) \
        __builtin_amdgcn_global_load_lds((const unsigned*)((const char*)(gbase) + (voff)[_i]), (LAS unsigned*)(lds + (bufoff) + ldsw + _i * 8192), 16, 0, 0); } while (0)
#define PG8_LDA(dst, b, h) do { _Pragma("unroll") for (int m = 0; m < 4; ++m) _Pragma("unroll") for (int k = 0; k < 2; ++k) dst[m][k] = *(const LAS bf16x8*)(lds + PG8_SA(b, h) + aoff + m * 2048 + k * 1024); } while (0)
#define PG8_LDB(dst, b, h) do { _Pragma("unroll") for (int n = 0; n < 2; ++n) _Pragma("unroll") for (int k = 0; k < 2; ++k) dst[n][k] = *(const LAS bf16x8*)(lds + PG8_SB(b, h) + boff + n * 2048 + k * 1024); } while (0)
#define PG8_MMA(ai, bj, At, Bt) do { __builtin_amdgcn_s_setprio(1); _Pragma("unroll") for (int m = 0; m < 4; ++m) _Pragma("unroll") for (int n = 0; n < 2; ++n) _Pragma("unroll") for (int k = 0; k < 2; ++k) \
        acc[ai][bj][m][n] = __builtin_amdgcn_mfma_f32_16x16x32_bf16(Bt[n][k], At[m][k], acc[ai][bj][m][n], 0, 0, 0); __builtin_amdgcn_s_setprio(0); } while (0)
#define PG8_WAIT_V(n) asm volatile("s_waitcnt vmcnt(" #n ")" ::: "memory")
#define PG8_WAIT_L(n) asm volatile("s_waitcnt lgkmcnt(" #n ")" ::: "memory")
#define PG8_BAR __builtin_amdgcn_s_barrier()
#define PG8_SCHED __builtin_amdgcn_sched_barrier(0)
    Unit cur, nxt; int ui = 0;
    if (!S.next(0, cur)) return;
    f32x4 acc[2][2][4][2];
#pragma unroll
    for (int a = 0; a < 2; ++a)
#pragma unroll
        for (int b = 0; b < 2; ++b)
#pragma unroll
            for (int m = 0; m < 4; ++m)
#pragma unroll
                for (int n = 0; n < 2; ++n) acc[a][b][m][n] = (f32x4){0.f, 0.f, 0.f, 0.f};
    bf16x8 At[4][2], B0[2][2], B1[2][2];
    const char* cA = (const char*)g.A + (size_t)cur.pm * tstep; const char* cB = (const char*)g.Bt + (size_t)cur.pn * tstep;
    PG8_STAGE(PG8_SB(0, 0), cB, voffB); PG8_STAGE(PG8_SB(0, 1), cB + hstep, voffB); PG8_STAGE(PG8_SA(0, 0), cA, voffA); PG8_STAGE(PG8_SA(0, 1), cA + hstep, voffA);
    if (SS) {
        int pms[8];
#pragma unroll
        for (int i = 0; i < 8; ++i) { Unit uu; pms[i] = S.next(i, uu) ? uu.pm : -1; }
        if (tid < 256) {
            f32x4 v[8][4];
#pragma unroll
            for (int i = 0; i < 8; ++i) if (pms[i] >= 0) { const f32x4* p = (const f32x4*)(SS + (size_t)(pms[i] * BM + tid) * 16);
#pragma unroll
                for (int q = 0; q < 4; ++q) v[i][q] = p[q]; }
#pragma unroll
            for (int i = 0; i < 8; ++i) if (pms[i] >= 0) { float sm = 0.f;
#pragma unroll
                for (int q = 0; q < 4; ++q) sm += (v[i][q][0] + v[i][q][1]) + (v[i][q][2] + v[i][q][3]);
                rsl[i * 256 + tid] = __builtin_amdgcn_rsqf(sm * (1.0f / 1024.0f) + EPS); }
        }
        __syncthreads();
    }
    if (wr == 1) PG8_BAR;
    PG8_WAIT_V(2); PG8_BAR;
    PG8_STAGE(PG8_SB(1, 0), cB + kstep, voffB); PG8_STAGE(PG8_SA(1, 0), cA + kstep, voffA); PG8_STAGE(PG8_SB(1, 1), cB + hstep + kstep, voffB);
    PG8_WAIT_V(6); PG8_BAR;
    for (;;) {
        const bool has_next = S.next(ui + 1, nxt);
        const char* nA = has_next ? (const char*)g.A + (size_t)nxt.pm * tstep : cA; const char* nB = has_next ? (const char*)g.Bt + (size_t)nxt.pn * tstep : cB;
        for (int t = 0; t < nt; t += 2) {
            const bool last = (t == nt - 2);
            const char* a1 = cA + (size_t)(t + 1) * kstep;
            const char* a2 = last ? nA : cA + (size_t)(t + 2) * kstep; const char* b2 = last ? nB : cB + (size_t)(t + 2) * kstep;
            const char* a3 = a2 + kstep; const char* b3 = b2 + kstep;
            PG8_LDB(B0, 0, 0); PG8_LDB(B1, 0, 1); PG8_SCHED; PG8_LDA(At, 0, 0); PG8_STAGE(PG8_SA(1, 1), a1 + hstep, voffA);
            PG8_WAIT_V(8); PG8_WAIT_L(0); PG8_BAR; PG8_MMA(0, 0, At, B0); PG8_MMA(0, 1, At, B1); PG8_BAR; PG8_SCHED;
            PG8_LDA(At, 0, 1); PG8_STAGE(PG8_SB(0, 0), b2, voffB); PG8_STAGE(PG8_SB(0, 1), b2 + hstep, voffB); PG8_STAGE(PG8_SA(0, 0), a2, voffA);
            PG8_WAIT_V(8); PG8_WAIT_L(0); PG8_BAR; PG8_MMA(1, 0, At, B0); PG8_MMA(1, 1, At, B1); PG8_BAR; PG8_SCHED;
            PG8_LDB(B0, 1, 0); PG8_LDB(B1, 1, 1); PG8_SCHED; PG8_LDA(At, 1, 0); PG8_STAGE(PG8_SA(0, 1), a2 + hstep, voffA);
            PG8_WAIT_V(8); PG8_WAIT_L(0); PG8_BAR; PG8_MMA(0, 0, At, B0); PG8_MMA(0, 1, At, B1); PG8_BAR; PG8_SCHED;
            PG8_LDA(At, 1, 1); PG8_STAGE(PG8_SB(1, 0), b3, voffB); PG8_STAGE(PG8_SB(1, 1), b3 + hstep, voffB); PG8_STAGE(PG8_SA(1, 0), a3, voffA);
            PG8_WAIT_V(8); PG8_WAIT_L(0); PG8_BAR; PG8_MMA(1, 0, At, B0); PG8_MMA(1, 1, At, B1); PG8_BAR; PG8_SCHED;
        }
        if (wr == 0) PG8_BAR;
        E(acc, cur, rsl + ui * 256, wr, wc, fr, fq);
        if (!has_next) break;
#pragma unroll
        for (int a = 0; a < 2; ++a)
#pragma unroll
            for (int b = 0; b < 2; ++b)
#pragma unroll
                for (int m = 0; m < 4; ++m)
#pragma unroll
                    for (int n = 0; n < 2; ++n) acc[a][b][m][n] = (f32x4){0.f, 0.f, 0.f, 0.f};
        cur = nxt; cA = nA; cB = nB; ++ui;
        if (wr == 1) PG8_BAR;
    }
    PG8_WAIT_V(0);
    PG8_BAR;
#undef PG8_SA
#undef PG8_SB
#undef PG8_STAGE
#undef PG8_LDA
#undef PG8_LDB
#undef PG8_MMA
#undef PG8_WAIT_V
#undef PG8_WAIT_L
#undef PG8_BAR
#undef PG8_SCHED
}
}

template <int MODE>
__device__ __forceinline__ void small_gemm(LAS unsigned char* lds, const bf16_t* A, const bf16_t* Bt, int K, int unit, float* X, bf16_t* XB, float* SS, float sc, bf16_t* OUT) {
    int tid = threadIdx.x; asm volatile("" : "+v"(tid));
    const int wave = __builtin_amdgcn_readfirstlane(tid >> 6), lane = tid & 63, li = lane & 15, g4 = lane >> 4;
    const int rt = unit >> 3, ct = unit & 7, row0 = TP + 16 * rt, col0 = 128 * ct;
    const int KS = K >> 8;
    const int row = tid >> 5, c4 = (tid & 31) * 4;
    const size_t off = (size_t)(row0 + row) * D + col0 + c4;
    u32x2 xw; f32x4 sv[4];
    if (MODE == 0) xw = *(const u32x2*)(XB + off);
    else {
#pragma unroll
        for (int q = 0; q < 4; ++q) sv[q] = ((const f32x4*)(SS + (size_t)(row0 + row) * 16))[q]; }
    f32x4 acc[8];
#pragma unroll
    for (int t = 0; t < 8; ++t) acc[t] = (f32x4){0.f, 0.f, 0.f, 0.f};
    const bf16_t* ap = A + (size_t)(row0 + li) * K + 8 * g4 + 32 * wave * KS;
    const bf16_t* bp = Bt + (size_t)(col0 + li) * K + 8 * g4 + 32 * wave * KS;
#pragma unroll 4
    for (int ks = 0; ks < KS; ++ks) {
        const bf16x8 a = *(const bf16x8*)(ap + 32 * ks);
#pragma unroll
        for (int t = 0; t < 8; ++t) { const bf16x8 b = *(const bf16x8*)(bp + (size_t)16 * t * K + 32 * ks); acc[t] = __builtin_amdgcn_mfma_f32_16x16x32_bf16(b, a, acc[t], 0, 0, 0); }
    }
    LAS float* red = (LAS float*)lds;
#pragma unroll
    for (int t = 0; t < 8; ++t) *(LAS f32x4*)(red + (wave * 16 + li) * 128 + 16 * t + 4 * g4) = acc[t];
    __syncthreads();
    f32x4 sum = *(LAS f32x4*)(red + row * 128 + c4);
#pragma unroll
    for (int w = 1; w < 8; ++w) sum += *(LAS f32x4*)(red + (w * 16 + row) * 128 + c4);
    if (MODE == 0) {
        f32x4 x = (f32x4){bf_lo(xw.x), bf_hi(xw.x), bf_lo(xw.y), bf_hi(xw.y)}; x += sum * sc;
        u32x2 w; w.x = cvt_pk_bf16(x[0], x[1]); w.y = cvt_pk_bf16(x[2], x[3]); *(u32x2*)(XB + off) = w;
        float ss = (x[0] * x[0] + x[1] * x[1]) + (x[2] * x[2] + x[3] * x[3]);
        ss += __shfl_xor(ss, 1); ss += __shfl_xor(ss, 2); ss += __shfl_xor(ss, 4); ss += __shfl_xor(ss, 8); ss += __shfl_xor(ss, 16);
        if ((tid & 31) == 0) SS[(size_t)(row0 + row) * 16 + ct] = ss;
    } else {
        float sm = 0.f;
#pragma unroll
        for (int q = 0; q < 4; ++q) sm += (sv[q][0] + sv[q][1]) + (sv[q][2] + sv[q][3]);
        const float rs = __builtin_amdgcn_rsqf(sm * (1.0f / 1024.0f) + EPS) * sc;
        u32x2 w; w.x = cvt_pk_bf16(sum[0] * rs, sum[1] * rs); w.y = cvt_pk_bf16(sum[2] * rs, sum[3] * rs); *(u32x2*)(OUT + off) = w;
    }
    __syncthreads();
}

__device__ __forceinline__ void small_gemm_res(LAS unsigned char* lds, const bf16_t* A, const bf16_t* Bt, int K, int unit, bf16_t* XB, float* SS, float sc) {
    int tid = threadIdx.x; asm volatile("" : "+v"(tid));
    const int wave = __builtin_amdgcn_readfirstlane(tid >> 6), lane = tid & 63, li = lane & 15, g4 = lane >> 4;
    const int ux = unit & 7, ur = unit >> 3;
    const int ct = 2 * ux + (ur & 1), rt = ur >> 1, row0 = TP + 32 * rt, col0 = 64 * ct;
    const int KS = K >> 8;
    const int row = tid >> 4, c4 = (tid & 15) * 4;
    const size_t off = (size_t)(row0 + row) * D + col0 + c4;
    const u32x2 xw = *(const u32x2*)(XB + off);
    f32x4 acc[2][4];
#pragma unroll
    for (int m = 0; m < 2; ++m)
#pragma unroll
        for (int t = 0; t < 4; ++t) acc[m][t] = (f32x4){0.f, 0.f, 0.f, 0.f};
    const bf16_t* ap = A + (size_t)(row0 + li) * K + 8 * g4 + 32 * wave * KS;
    const bf16_t* bp = Bt + (size_t)(col0 + li) * K + 8 * g4 + 32 * wave * KS;
#pragma unroll 6
    for (int ks = 0; ks < KS; ++ks) {
        const bf16x8 a0 = *(const bf16x8*)(ap + 32 * ks), a1 = *(const bf16x8*)(ap + (size_t)16 * K + 32 * ks);
#pragma unroll
        for (int t = 0; t < 4; ++t) { const bf16x8 b = *(const bf16x8*)(bp + (size_t)16 * t * K + 32 * ks);
            acc[0][t] = __builtin_amdgcn_mfma_f32_16x16x32_bf16(b, a0, acc[0][t], 0, 0, 0); acc[1][t] = __builtin_amdgcn_mfma_f32_16x16x32_bf16(b, a1, acc[1][t], 0, 0, 0); }
    }
    LAS float* red = (LAS float*)lds;
#pragma unroll
    for (int m = 0; m < 2; ++m)
#pragma unroll
        for (int t = 0; t < 4; ++t) *(LAS f32x4*)(red + (wave * 32 + 16 * m + li) * 64 + 16 * t + 4 * g4) = acc[m][t];
    __syncthreads();
    f32x4 sum = *(LAS f32x4*)(red + row * 64 + c4);
#pragma unroll
    for (int w = 1; w < 8; ++w) sum += *(LAS f32x4*)(red + (w * 32 + row) * 64 + c4);
    f32x4 x = (f32x4){bf_lo(xw.x), bf_hi(xw.x), bf_lo(xw.y), bf_hi(xw.y)}; x += sum * sc;
    u32x2 w; w.x = cvt_pk_bf16(x[0], x[1]); w.y = cvt_pk_bf16(x[2], x[3]); *(u32x2*)(XB + off) = w;
    float ss = (x[0] * x[0] + x[1] * x[1]) + (x[2] * x[2] + x[3] * x[3]);
    ss += __shfl_xor(ss, 1); ss += __shfl_xor(ss, 2); ss += __shfl_xor(ss, 4); ss += __shfl_xor(ss, 8);
    if ((tid & 15) == 0) SS[(size_t)(row0 + row) * 16 + ct] = ss;
    __syncthreads();
}

__device__ __forceinline__ void small_gemm_q256(LAS unsigned char* lds, const bf16_t* A, const bf16_t* Bt, int unit, const float* SS, float sc, bf16_t* OUT) {
    int tid = threadIdx.x; asm volatile("" : "+v"(tid));
    const int wave = __builtin_amdgcn_readfirstlane(tid >> 6), lane = tid & 63, li = lane & 15, g4 = lane >> 4;
    const int rt = unit >> 2, ct = unit & 3, row0 = TP + 16 * rt, col0 = 256 * ct;
    constexpr int K = D, KS = 4;
    const int row = tid >> 5;
    f32x4 sv[4];
#pragma unroll
    for (int q = 0; q < 4; ++q) sv[q] = ((const f32x4*)(SS + (size_t)(row0 + row) * 16))[q];
    f32x4 acc[16];
#pragma unroll
    for (int t = 0; t < 16; ++t) acc[t] = (f32x4){0.f, 0.f, 0.f, 0.f};
    const bf16_t* ap = A + (size_t)(row0 + li) * K + 8 * g4 + 32 * wave * KS;
    const bf16_t* bp = Bt + (size_t)(col0 + li) * K + 8 * g4 + 32 * wave * KS;
#pragma unroll 2
    for (int ks = 0; ks < KS; ++ks) {
        const bf16x8 a = *(const bf16x8*)(ap + 32 * ks);
#pragma unroll
        for (int t = 0; t < 16; ++t) { const bf16x8 b = *(const bf16x8*)(bp + (size_t)16 * t * K + 32 * ks); acc[t] = __builtin_amdgcn_mfma_f32_16x16x32_bf16(b, a, acc[t], 0, 0, 0); }
    }
    LAS float* red = (LAS float*)lds;
#pragma unroll
    for (int t = 0; t < 16; ++t) *(LAS f32x4*)(red + (wave * 16 + li) * 256 + 16 * t + 4 * g4) = acc[t];
    __syncthreads();
    float sm = 0.f;
#pragma unroll
    for (int q = 0; q < 4; ++q) sm += (sv[q][0] + sv[q][1]) + (sv[q][2] + sv[q][3]);
    const float rs = __builtin_amdgcn_rsqf(sm * (1.0f / 1024.0f) + EPS) * sc;
#pragma unroll
    for (int cc = 0; cc < 2; ++cc) {
        const int c4 = (tid & 31) * 4 + 128 * cc;
        f32x4 sum = *(LAS f32x4*)(red + row * 256 + c4);
#pragma unroll
        for (int w = 1; w < 8; ++w) sum += *(LAS f32x4*)(red + (w * 16 + row) * 256 + c4);
        u32x2 w; w.x = cvt_pk_bf16(sum[0] * rs, sum[1] * rs); w.y = cvt_pk_bf16(sum[2] * rs, sum[3] * rs);
        *(u32x2*)(OUT + (size_t)(row0 + row) * D + col0 + c4) = w;
    }
    asm volatile("s_waitcnt vmcnt(0)" ::: "memory");
    __syncthreads();
}

__device__ __forceinline__ void transpose_item(const float* W, int K, int N, const float* gain, bf16_t* WT, int dst_row0, LAS float* scr, int kb, int n0, int lane) {
    const int k0 = 64 * kb, n4 = (lane & 7) * 4, kr = lane >> 3;
    f32x4 v[8]; float g[8];
#pragma unroll
    for (int i = 0; i < 8; ++i) { v[i] = *(const f32x4*)(W + (size_t)(k0 + kr + 8 * i) * N + n0 + n4); g[i] = gain ? gain[k0 + kr + 8 * i] : 1.0f; }
#pragma unroll
    for (int i = 0; i < 8; ++i) { LAS float* d = scr + (kr + 8 * i) * 33 + n4; d[0] = v[i][0] * g[i]; d[1] = v[i][1] * g[i]; d[2] = v[i][2] * g[i]; d[3] = v[i][3] * g[i]; }
    asm volatile("s_waitcnt lgkmcnt(0)" ::: "memory");
    const int c = lane & 7;
#pragma unroll
    for (int j = 0; j < 4; ++j) { const int n = (lane >> 3) + 8 * j; const LAS float* s = scr + (8 * c) * 33 + n;
        u32x4 o; o.x = cvt_pk_bf16(s[0 * 33], s[1 * 33]); o.y = cvt_pk_bf16(s[2 * 33], s[3 * 33]); o.z = cvt_pk_bf16(s[4 * 33], s[5 * 33]); o.w = cvt_pk_bf16(s[6 * 33], s[7 * 33]);
        *(u32x4*)(WT + (size_t)(dst_row0 + n) * K + k0 + 8 * c) = o; }
    asm volatile("s_waitcnt lgkmcnt(0)" ::: "memory");
}

constexpr int WI_UP = 16 * 88, WI_DN = 44 * 32, WI_IN = 16 * 80, WI_SQ = 16 * 32;
constexpr int W_PER_L = 4 * WI_UP + 2 * WI_DN + WI_IN + 5 * WI_SQ, W_NOKV = W_PER_L - 2 * WI_SQ;
__device__ __forceinline__ void weight_item(const Params& P, unsigned char* ws, LAS float* scr, int l, int r, int lane) {
    constexpr int I_UP = WI_UP, I_DN = WI_DN, I_IN = WI_IN, I_SQ = WI_SQ;
        bf16_t* W1a = (bf16_t*)(ws + WS_W1) + (size_t)(2 * l) * 2 * DFF * D; bf16_t* W1b = W1a + (size_t)2 * DFF * D;
        bf16_t* WDa = (bf16_t*)(ws + WS_WD) + (size_t)(2 * l) * D * DFF; bf16_t* WDb = WDa + (size_t)D * DFF;
        const size_t oU = (size_t)l * D * DFF, oS = (size_t)l * D * D;
#define TR_UP(IDX, GIDX, WT, ISUP) { const int kb = r / 88, n0 = (r % 88) * 32; transpose_item(P.in[IDX] + oU, D, DFF, P.in[GIDX] + l * D, WT, (n0 >> 7) * 256 + (n0 & 127) + (ISUP) * 128, scr, kb, n0, lane); return; }
        if (r < I_UP) TR_UP(10, 9, W1a, 0)
        r -= I_UP;
        if (r < I_UP) TR_UP(11, 9, W1a, 1)
        r -= I_UP;
        if (r < I_UP) TR_UP(28, 27, W1b, 0)
        r -= I_UP;
        if (r < I_UP) TR_UP(29, 27, W1b, 1)
        r -= I_UP;
#undef TR_UP
        if (r < I_DN) { const int kb = r / 32, n0 = (r % 32) * 32; transpose_item(P.in[12] + oU, DFF, D, nullptr, WDa, n0, scr, kb, n0, lane); return; }
        r -= I_DN;
        if (r < I_DN) { const int kb = r / 32, n0 = (r % 32) * 32; transpose_item(P.in[30] + oU, DFF, D, nullptr, WDb, n0, scr, kb, n0, lane); return; }
        r -= I_DN;
        if (r < I_IN) { const int kb = r / 80, n0 = (r % 80) * 32; transpose_item(P.in[14] + (size_t)l * D * DIN, D, DIN, P.in[13] + l * D, (bf16_t*)(ws + WS_WIN) + (size_t)l * DIN * D, n0, scr, kb, n0, lane); return; }
        r -= I_IN;
        {
            const int q = r / I_SQ; r %= I_SQ; const int kb = r / 32, n0 = (r % 32) * 32;
            if (q == 0) transpose_item(P.in[20] + oS, D, D, P.in[19] + l * D, (bf16_t*)(ws + WS_WOUT) + oS, n0, scr, kb, n0, lane);
            else if (q == 1) transpose_item(P.in[23] + oS, D, D, P.in[21] + l * D, (bf16_t*)(ws + WS_WXQ) + oS, n0, scr, kb, n0, lane);
            else if (q == 2) transpose_item(P.in[26] + oS, D, D, nullptr, (bf16_t*)(ws + WS_WXO) + oS, n0, scr, kb, n0, lane);
            else if (q == 3) transpose_item(P.in[24] + oS, D, D, P.in[22] + l * D, (bf16_t*)(ws + WS_WKV), l * 2048 + n0, scr, kb, n0, lane);
            else transpose_item(P.in[25] + oS, D, D, P.in[22] + l * D, (bf16_t*)(ws + WS_WKV), l * 2048 + 1024 + n0, scr, kb, n0, lane);
        }
}
__device__ __forceinline__ void weights_deferred(const Params& P, LAS unsigned char* lds, int l, int part, int nparts) {
    int tid = threadIdx.x; asm volatile("" : "+v"(tid));
    const int lane = tid & 63, wave = __builtin_amdgcn_readfirstlane(tid >> 6);
    LAS float* scr = (LAS float*)(lds + wave * 16384);
    for (int r = part * NW + wave; r < W_NOKV; r += nparts * NW) weight_item(P, P.ws, scr, l, r, lane);
}

__device__ __forceinline__ void cache_convert(const Params& P, int l, int pct0, int pct1, int part, int nparts);
__device__ __forceinline__ void prologue(const Params& P, LAS unsigned char* lds, int G, int vcu) {
    int tid = threadIdx.x; asm volatile("" : "+v"(tid));
    const int lane = tid & 63, wave = __builtin_amdgcn_readfirstlane(tid >> 6);
    LAS float* scr = (LAS float*)(lds + wave * 16384);
    unsigned char* ws = P.ws;
    const int gw = vcu * NW + wave, NGW = G * NW;
    for (int it = gw; it < NL * W_PER_L; it += NGW) weight_item(P, ws, scr, it / W_PER_L, it % W_PER_L, lane);
    float* X = (float*)(ws + WS_X); bf16_t* XB = (bf16_t*)(ws + WS_XB); float* SS = (float*)(ws + WS_SS);
    for (int m = gw; m < T + 512; m += NGW) {
        const bool ismem = m >= T;
        const float* xp0 = P.in[0]; const float* xs0 = P.in[1]; const float* mp0 = P.in[2];
        const float* src = ismem ? mp0 + (size_t)(m - T) * D : (m < TP ? xp0 + (size_t)m * D : xs0 + (size_t)(m - TP) * D);
        f32x4 v[4]; float ss = 0.f;
#pragma unroll
        for (int j = 0; j < 4; ++j) { v[j] = ((const f32x4*)src)[lane + 64 * j]; ss += (v[j][0] * v[j][0] + v[j][1] * v[j][1]) + (v[j][2] * v[j][2] + v[j][3] * v[j][3]); }
        ss = wave_sum(ss);
        bf16_t* xb = ismem ? (bf16_t*)(ws + WS_MEMB) + (size_t)(m - T) * D : XB + (size_t)m * D;
        float* ssp = ismem ? (float*)(ws + WS_SSM) + (size_t)(m - T) * 16 : SS + (size_t)m * 16;
#pragma unroll
        for (int j = 0; j < 4; ++j) {
            u32x2 w; w.x = cvt_pk_bf16(v[j][0], v[j][1]); w.y = cvt_pk_bf16(v[j][2], v[j][3]);
            ((u32x2*)xb)[lane + 64 * j] = w;
        }
        if (lane < 16) ssp[lane] = lane == 0 ? ss : 0.f;
    }
    {
        bf16_t* HZC = (bf16_t*)(ws + WS_HZC); bf16_t* HZP = (bf16_t*)(ws + WS_HZP);
        for (int i = (vcu * NW + wave) * 64 + lane; i < NL * 32 * 2 * 256; i += NGW * 64) HZC[i] = (bf16_t)(cvt_pk_bf16(P.in[5][i], 0.f) & 0xffffu);
        for (int i = (vcu * NW + wave) * 64 + lane; i < NL * 32 * 15 * 256; i += NGW * 64) HZP[i] = (bf16_t)(cvt_pk_bf16(P.in[6][i], 0.f) & 0xffffu);
    }
    bf16_t* PWT = (bf16_t*)(ws + WS_PWT);
    for (int i = (vcu * NW + wave) * 64 + lane; i < NL * 4 * 64 * 64; i += NGW * 64) {
        const int c = i & 63, dout = (i >> 6) & 63, lg = i >> 12;
        const float v = P.in[17][((size_t)lg * 64 + c) * 64 + dout] * P.in[18][lg * 64 + dout];
        PWT[i] = (bf16_t)(cvt_pk_bf16(v, 0.f) & 0xffffu);
    }
}

__device__ __forceinline__ void cache_convert(const Params& P, int l, int pct0, int pct1, int part, int nparts) {
    int tid = threadIdx.x; asm volatile("" : "+v"(tid));
    constexpr unsigned NGL = 32u * 512u * 512u / 8u;
    const unsigned g0 = (unsigned)((unsigned long long)(2u * NGL) * pct0 / 100u), g1 = (unsigned)((unsigned long long)(2u * NGL) * pct1 / 100u);
    const float* ck = P.in[3] + (size_t)l * 32 * 512 * 512; const float* cv = P.in[4] + (size_t)l * 32 * 512 * 512;
    bf16_t* kb = (bf16_t*)(P.ws + WS_KB16) + (size_t)l * 32 * 512 * 512; bf16_t* vb = (bf16_t*)(P.ws + WS_VB16) + (size_t)l * 32 * 512 * 512;
    float* ok = P.out + OFF_KS + (size_t)l * 32 * 512 * 512; float* ov = P.out + OFF_VS + (size_t)l * 32 * 512 * 512;
#pragma unroll 8
    for (unsigned gi = g0 + (unsigned)part * 512u + tid; gi < g1; gi += (unsigned)nparts * 512u) {
        const bool isv = gi >= NGL; const unsigned e = (isv ? gi - NGL : gi) * 8u; const int key = (int)((e >> 9) & 511u);
        const float* src = (isv ? cv : ck) + e;
        const f32x4 k0 = *(const f32x4*)src, k1 = *(const f32x4*)(src + 4);
        *(bf16x8*)((isv ? vb : kb) + e) = pack8v(k0, k1);
        if (key >= 16) { float* d = (isv ? ov : ok) + e - 16 * 512; *(f32x4*)d = k0; *(f32x4*)(d + 4) = k1; }
    }
}

__device__ __forceinline__ void store_block32_wide(bf16_t* rowp, const f32x16& o, float sc, int hi, bool do_store) {
#pragma unroll
    for (int p = 0; p < 2; ++p) {
        const unsigned x0 = cvt_pk_bf16(o[8 * p + 0] * sc, o[8 * p + 1] * sc), x1 = cvt_pk_bf16(o[8 * p + 2] * sc, o[8 * p + 3] * sc);
        const unsigned y0 = cvt_pk_bf16(o[8 * p + 4] * sc, o[8 * p + 5] * sc), y1 = cvt_pk_bf16(o[8 * p + 6] * sc, o[8 * p + 7] * sc);
        const auto r0 = __builtin_amdgcn_permlane32_swap(x0, y0, false, false);
        const auto r1 = __builtin_amdgcn_permlane32_swap(x1, y1, false, false);
        u32x4 w; w.x = r0[0]; w.y = r1[0]; w.z = r0[1]; w.w = r1[1];
        if (do_store) *(u32x4*)(rowp + 16 * p + 8 * hi) = w;
    }
}

__device__ __forceinline__ int voff_band(int key, int d) { return ((key >> 3) * 2 + (d >> 5)) * 512 + (key & 7) * 64 + (d & 31) * 2; }
__device__ __forceinline__ void store8f(float* p, const float* f) { *(f32x4*)p = (f32x4){f[0], f[1], f[2], f[3]}; *(f32x4*)(p + 4) = (f32x4){f[4], f[5], f[6], f[7]}; }
__device__ __forceinline__ bf16x8 load8f_bf(const float* p) { const f32x4 a = *(const f32x4*)p, b = *(const f32x4*)(p + 4); return pack8v(a, b); }

struct AttnState { f32x16 O[2]; float mrun, lsum; };
__device__ __forceinline__ int koff_band(int row, int chunk) { return row * 128 + ((chunk ^ ((row >> 1) & 7)) << 4); }
__device__ __forceinline__ void attn_score(AttnState& st, bf16x8 (&pf)[2], const bf16x8 (&kf)[4], const bf16x8 (&qf)[4], int j, int qi, bool mask_hi, LAS float* tab, float tconst, int lane);
__device__ __forceinline__ void k_frags(bf16x8 (&kf)[4], const bf16x8 (&kraw)[4], LAS unsigned char* kst, int lane) {
    const int hi = lane >> 5, r = lane & 31;
#pragma unroll
    for (int i = 0; i < 4; ++i) *(LAS bf16x8*)(kst + koff_band((lane >> 3) + 8 * i, lane & 7)) = kraw[i];
#pragma unroll
    for (int d0 = 0; d0 < 4; ++d0) kf[d0] = *(const LAS bf16x8*)(kst + koff_band(r, 2 * d0 + hi));
}
__device__ __forceinline__ void attn_qk(AttnState& st, bf16x8 (&pf)[2], const bf16x8 (&kraw)[4], const bf16x8 (&qf)[4], int j, int qi, bool mask_hi,
                                        LAS float* tab, float tconst, LAS unsigned char* kst, int lane) {
    bf16x8 kf[4];
    k_frags(kf, kraw, kst, lane);
    attn_score(st, pf, kf, qf, j, qi, mask_hi, tab, tconst, lane);
}
__device__ __forceinline__ void attn_score(AttnState& st, bf16x8 (&pf)[2], const bf16x8 (&kf)[4], const bf16x8 (&qf)[4], int j, int qi, bool mask_hi,
                                           LAS float* tab, float tconst, int lane) {
    constexpr float C2 = 0.125f * LOG2E;
    const int hi = lane >> 5;
    f32x16 s;
#pragma unroll
    for (int e = 0; e < 16; ++e) s[e] = 0.f;
#pragma unroll
    for (int d0 = 0; d0 < 4; ++d0) s = __builtin_amdgcn_mfma_f32_32x32x16_bf16(kf[d0], qf[d0], s, 0, 0, 0);
    if (j >= 12) {
        const int base = 512 + qi - 32 * j - 4 * hi;
#pragma unroll
        for (int e = 0; e < 16; ++e) { int rel = base - ((e & 3) + 8 * (e >> 2)); rel = rel < 128 ? rel : 128; s[e] = s[e] * C2 + tab[rel + 128]; }
    } else {
#pragma unroll
        for (int e = 0; e < 16; ++e) s[e] = s[e] * C2 + tconst;
    }
    if (mask_hi) {
#pragma unroll
        for (int e = 8; e < 16; ++e) s[e] = -1e30f;
    }
    float mx = s[0];
#pragma unroll
    for (int e = 1; e < 16; ++e) mx = fmaxf(mx, s[e]);
    mx = fmaxf(mx, __shfl_xor(mx, 32));
    if (__any(mx > st.mrun + 8.0f)) {
        const float mnew = fmaxf(st.mrun, mx);
        const float alpha = __builtin_amdgcn_exp2f(st.mrun - mnew);
        st.mrun = mnew; st.lsum *= alpha;
#pragma unroll
        for (int db = 0; db < 2; ++db)
#pragma unroll
            for (int e = 0; e < 16; ++e) st.O[db][e] *= alpha;
    }
    float ps = 0.f;
#pragma unroll
    for (int e = 0; e < 16; ++e) { s[e] = __builtin_amdgcn_exp2f(s[e] - st.mrun); ps += s[e]; }
    st.lsum += ps;
#pragma unroll
    for (int s2 = 0; s2 < 2; ++s2) { u32x4 w; w.x = cvt_pk_bf16(s[8 * s2 + 0], s[8 * s2 + 1]); w.y = cvt_pk_bf16(s[8 * s2 + 2], s[8 * s2 + 3]); w.z = cvt_pk_bf16(s[8 * s2 + 4], s[8 * s2 + 5]); w.w = cvt_pk_bf16(s[8 * s2 + 6], s[8 * s2 + 7]);
        pf[s2] = __builtin_bit_cast(bf16x8, w); }
}
__device__ __forceinline__ void attn_pv(AttnState& st, const bf16x8 (&pf)[2], const bf16x8 (&vv)[4], LAS unsigned char* vst, int lane) {
    const int hi = lane >> 5;
#pragma unroll
    for (int i = 0; i < 4; ++i) { const int vr = (lane >> 3) + 8 * i, ch = lane & 7; *(LAS bf16x8*)(vst + voff_band(vr, 8 * ch)) = vv[i]; }
    const int trow = 4 * hi + ((lane & 15) >> 2), tcol = 16 * ((lane >> 4) & 1) + 4 * (lane & 3);
#pragma unroll
    for (int db = 0; db < 2; ++db)
#pragma unroll
        for (int s2 = 0; s2 < 2; ++s2) {
            const s16x4 a0 = tr_read(vst + voff_band(16 * s2 + trow, 32 * db + tcol));
            const s16x4 a1 = tr_read(vst + voff_band(16 * s2 + 8 + trow, 32 * db + tcol));
            const bf16x8 vf = (bf16x8){a0[0], a0[1], a0[2], a0[3], a1[0], a1[1], a1[2], a1[3]};
            st.O[db] = __builtin_amdgcn_mfma_f32_32x32x16_bf16(vf, pf[s2], st.O[db], 0, 0, 0);
        }
}

template <bool SAMPLE>
__device__ __forceinline__ void band_attn(const Params& P, int l, int b, int c, int h, int qb0, int jlo, int jhi, LAS unsigned char* wl, int lane_) {
    int lane = lane_; asm volatile("" : "+v"(lane));
    const int r = lane & 31, hi = lane >> 5;
    LAS float* tab = (LAS float*)wl;
    LAS unsigned char* vst = wl + 2048;
    LAS unsigned char* kst = wl + 6144;
    const bf16_t* Z = (const bf16_t*)(P.ws + WS_Z);
    bf16_t* MIX = (bf16_t*)(P.ws + WS_MIX);
    const float* rb = P.in[15] + (size_t)(l * 8 + h) * 257;
    for (int i = lane; i < 257; i += 64) tab[i] = rb[i] * LOG2E;
    const int qrow0 = SAMPLE ? (TP + b * 16) : (b * SEQ + c * 64);
    const int qi = SAMPLE ? (r & 15) : (32 * qb0 + r);
    bf16x8 qf[4];
#pragma unroll
    for (int d0 = 0; d0 < 4; ++d0) qf[d0] = *(const bf16x8*)(Z + (size_t)(qrow0 + qi) * DIN + h * 64 + 16 * d0 + 8 * hi);
    AttnState st; st.mrun = -1e30f; st.lsum = 0.f;
#pragma unroll
    for (int db = 0; db < 2; ++db)
#pragma unroll
        for (int e = 0; e < 16; ++e) st.O[db][e] = 0.f;
    const float tconst = tab[256];
    const int vr0 = lane >> 3, vch = lane & 7;
    const int NB = jhi;
    const int jb0 = SAMPLE ? jlo : (c < 8 ? (8 - c) * 2 : 0);
    const int krow0 = b * SEQ + (c - 8) * 64;
    const size_t cb = (size_t)(l * 32 + b) * 512;
    const bf16_t* KB = (const bf16_t*)(P.ws + WS_KB16); const bf16_t* VB = (const bf16_t*)(P.ws + WS_VB16);
#define KPTR(j, i) (SAMPLE ? ((j) < 16 ? KB + ((cb + 32 * (j) + vr0 + 8 * (i)) * 8 + h) * 64 + 8 * vch : Z + (size_t)(qrow0 + ((vr0 + 8 * (i)) & 15)) * DIN + 512 + h * 64 + 8 * vch) \
                           : Z + (size_t)(krow0 + 32 * (j) + vr0 + 8 * (i)) * DIN + 512 + h * 64 + 8 * vch)
#define VPTR(j, i) (SAMPLE ? ((j) < 16 ? VB + ((cb + 32 * (j) + vr0 + 8 * (i)) * 8 + h) * 64 + 8 * vch : Z + (size_t)(qrow0 + ((vr0 + 8 * (i)) & 15)) * DIN + 1024 + h * 64 + 8 * vch) \
                           : Z + (size_t)(krow0 + 32 * (j) + vr0 + 8 * (i)) * DIN + 1024 + h * 64 + 8 * vch)
    bf16x8 kc[4], kn[4], kn2[4], vc[4], vn[4];
    {
#pragma unroll
      for (int i = 0; i < 4; ++i) kc[i] = *(const bf16x8*)(KPTR(jb0, i));
#pragma unroll
      for (int i = 0; i < 4; ++i) vc[i] = *(const bf16x8*)(VPTR(jb0, i));
#pragma unroll
      for (int i = 0; i < 4; ++i) kn[i] = *(const bf16x8*)(KPTR(jb0 + 1, i)); }
    for (int j = jb0; j < NB; ++j) {
        if (j + 2 < NB) {
#pragma unroll
            for (int i = 0; i < 4; ++i) kn2[i] = *(const bf16x8*)(KPTR(j + 2, i)); }
        if (j + 1 < NB) {
#pragma unroll
            for (int i = 0; i < 4; ++i) vn[i] = *(const bf16x8*)(VPTR(j + 1, i)); }
        bf16x8 pf[2];
        attn_qk(st, pf, kc, qf, j, qi, SAMPLE && j == 16, tab, tconst, kst, lane);
        if (!SAMPLE) {
            if (c >= 120 && j >= 16 && qb0 == 0) {
                const size_t ob = (size_t)((l * 2 + b) * 512 + (c - 120) * 64 + 32 * (j - 16));
#pragma unroll
                for (int i = 0; i < 4; ++i) { float f[8]; unpack8(vc[i], f); store8f(P.out + OFF_VP + ((ob + vr0 + 8 * i) * 8 + h) * 64 + 8 * vch, f); }
#pragma unroll
                for (int i = 0; i < 4; ++i) { float f[8]; unpack8(kc[i], f); store8f(P.out + OFF_KP + ((ob + vr0 + 8 * i) * 8 + h) * 64 + 8 * vch, f); }
            }
        } else {
            if (j == 16) {
#pragma unroll
                for (int i = 0; i < 2; ++i) { float f[8]; unpack8(kc[i], f); store8f(P.out + OFF_KS + ((cb + 496 + vr0 + 8 * i) * 8 + h) * 64 + 8 * vch, f);
                    unpack8(vc[i], f); store8f(P.out + OFF_VS + ((cb + 496 + vr0 + 8 * i) * 8 + h) * 64 + 8 * vch, f); }
            }
        }
        attn_pv(st, pf, vc, vst, lane);
#pragma unroll
        for (int d0 = 0; d0 < 4; ++d0) { kc[d0] = kn[d0]; kn[d0] = kn2[d0]; vc[d0] = vn[d0]; }
    }
#undef KPTR
#undef VPTR
    float ls = st.lsum; ls += __shfl_xor(ls, 32);
    if (SAMPLE) {
        LAS float* op = (LAS float*)(wl + 10240); LAS float* ml = (LAS float*)(wl + 14336);
        if (r < 16) {
#pragma unroll
            for (int db = 0; db < 2; ++db)
#pragma unroll
                for (int e = 0; e < 16; ++e) op[(32 * db + (e & 3) + 8 * (e >> 2) + 4 * hi) * 16 + r] = st.O[db][e];
            if (hi == 0) { ml[2 * r] = st.mrun; ml[2 * r + 1] = ls; }
        }
        return;
    }
    const float inv = 1.0f / ls;
    float ssq = 0.f;
#pragma unroll
    for (int db = 0; db < 2; ++db)
#pragma unroll
        for (int e = 0; e < 16; ++e) { st.O[db][e] *= inv; ssq += st.O[db][e] * st.O[db][e]; }
    ssq += __shfl_xor(ssq, 32);
    const float rn = __builtin_amdgcn_rsqf(ssq * (1.0f / 64.0f) + EPS);
    if (!SAMPLE || r < 16) {
        bf16_t* op = MIX + (size_t)(qrow0 + qi) * D + h * 64 + 4 * hi;
#pragma unroll
        for (int db = 0; db < 2; ++db)
#pragma unroll
            for (int g4 = 0; g4 < 4; ++g4) { u32x2 w; w.x = cvt_pk_bf16(st.O[db][4 * g4] * rn, st.O[db][4 * g4 + 1] * rn); w.y = cvt_pk_bf16(st.O[db][4 * g4 + 2] * rn, st.O[db][4 * g4 + 3] * rn);
                *(u32x2*)(op + 32 * db + 8 * g4) = w; }
    }
}

__device__ __forceinline__ void band_attn_p2(const Params& P, int l, int b, int c, int h, LAS unsigned char* wl, int lane_) {
    int lane = lane_; asm volatile("" : "+v"(lane));
    const int r = lane & 31, hi = lane >> 5;
    LAS float* tab = (LAS float*)wl;
    LAS unsigned char* vst = wl + 2048;
    LAS unsigned char* kst = wl + 6144;
    const bf16_t* Z = (const bf16_t*)(P.ws + WS_Z);
    bf16_t* MIX = (bf16_t*)(P.ws + WS_MIX);
    const float* rb = P.in[15] + (size_t)(l * 8 + h) * 257;
    for (int i = lane; i < 257; i += 64) tab[i] = rb[i] * LOG2E;
    const int qrow0 = b * SEQ + c * 64;
    bf16x8 qf[2][4];
    AttnState st[2];
#pragma unroll
    for (int qb = 0; qb < 2; ++qb) {
#pragma unroll
        for (int d0 = 0; d0 < 4; ++d0) qf[qb][d0] = *(const bf16x8*)(Z + (size_t)(qrow0 + 32 * qb + r) * DIN + h * 64 + 16 * d0 + 8 * hi);
        st[qb].mrun = -1e30f; st[qb].lsum = 0.f;
#pragma unroll
        for (int db = 0; db < 2; ++db)
#pragma unroll
            for (int e = 0; e < 16; ++e) st[qb].O[db][e] = 0.f;
    }
    const float tconst = tab[256];
    const int vr0 = lane >> 3, vch = lane & 7;
    const int jb0 = c < 8 ? (8 - c) * 2 : 0;
    const bf16_t* zb = Z + (size_t)(b * SEQ + (c - 8) * 64 + vr0) * DIN + h * 64 + 8 * vch;
    bf16x8 kc[4], kn[4], vc[4];
#pragma unroll
    for (int i = 0; i < 4; ++i) kc[i] = *(const bf16x8*)(zb + (size_t)(32 * jb0 + 8 * i) * DIN + 512);
    for (int j = jb0; j < 18; ++j) {
#pragma unroll
        for (int i = 0; i < 4; ++i) vc[i] = *(const bf16x8*)(zb + (size_t)(32 * j + 8 * i) * DIN + 1024);
        if (j + 1 < 18) {
#pragma unroll
            for (int i = 0; i < 4; ++i) kn[i] = *(const bf16x8*)(zb + (size_t)(32 * (j + 1) + 8 * i) * DIN + 512);
        }
        bf16x8 kf[4], pf[2][2];
        k_frags(kf, kc, kst, lane);
#pragma unroll
        for (int qb = 0; qb < 2; ++qb) attn_score(st[qb], pf[qb], kf, qf[qb], j, 32 * qb + r, false, tab, tconst, lane);
#pragma unroll
        for (int i = 0; i < 4; ++i) *(LAS bf16x8*)(vst + voff_band(vr0 + 8 * i, 8 * vch)) = vc[i];
        const int trow = 4 * hi + ((lane & 15) >> 2), tcol = 16 * ((lane >> 4) & 1) + 4 * (lane & 3);
#pragma unroll
        for (int db = 0; db < 2; ++db)
#pragma unroll
            for (int s2 = 0; s2 < 2; ++s2) {
                const s16x4 a0 = tr_read(vst + voff_band(16 * s2 + trow, 32 * db + tcol));
                const s16x4 a1 = tr_read(vst + voff_band(16 * s2 + 8 + trow, 32 * db + tcol));
                const bf16x8 vf = (bf16x8){a0[0], a0[1], a0[2], a0[3], a1[0], a1[1], a1[2], a1[3]};
#pragma unroll
                for (int qb = 0; qb < 2; ++qb) st[qb].O[db] = __builtin_amdgcn_mfma_f32_32x32x16_bf16(vf, pf[qb][s2], st[qb].O[db], 0, 0, 0);
            }
#pragma unroll
        for (int i = 0; i < 4; ++i) kc[i] = kn[i];
    }
    if (c >= 120) {
        const size_t ob = (size_t)((l * 2 + b) * 512 + (c - 120) * 64);
        for (int i = 0; i < 8; ++i) { const int row = vr0 + 8 * i; float f[8];
            unpack8(*(const bf16x8*)(Z + (size_t)(qrow0 + row) * DIN + 512 + h * 64 + 8 * vch), f); store8f(P.out + OFF_KP + ((ob + row) * 8 + h) * 64 + 8 * vch, f);
            unpack8(*(const bf16x8*)(Z + (size_t)(qrow0 + row) * DIN + 1024 + h * 64 + 8 * vch), f); store8f(P.out + OFF_VP + ((ob + row) * 8 + h) * 64 + 8 * vch, f); }
    }
#pragma unroll
    for (int qb = 0; qb < 2; ++qb) {
        float ls = st[qb].lsum; ls += __shfl_xor(ls, 32);
        const float inv = 1.0f / ls;
        float ssq = 0.f;
#pragma unroll
        for (int db = 0; db < 2; ++db)
#pragma unroll
            for (int e = 0; e < 16; ++e) { st[qb].O[db][e] *= inv; ssq += st[qb].O[db][e] * st[qb].O[db][e]; }
        ssq += __shfl_xor(ssq, 32);
        const float rn = __builtin_amdgcn_rsqf(ssq * (1.0f / 64.0f) + EPS);
        bf16_t* op = MIX + (size_t)(qrow0 + 32 * qb + r) * D + h * 64;
#pragma unroll
        for (int db = 0; db < 2; ++db) store_block32_wide(op + 32 * db, st[qb].O[db], rn, hi, true);
    }
}

__device__ __forceinline__ void sample_merge(const Params& P, int b, int h, LAS unsigned char* lds, int lane_) {
    int lane = lane_; asm volatile("" : "+v"(lane));
    bf16_t* MIX = (bf16_t*)(P.ws + WS_MIX);
    const int q = lane & 15, dq = lane >> 4;
    float mw[8], M = -1e30f;
#pragma unroll
    for (int w = 0; w < 8; ++w) { mw[w] = ((const LAS float*)(lds + w * 16384 + 14336))[2 * q]; M = fmaxf(M, mw[w]); }
    float L = 0.f, o[16];
#pragma unroll
    for (int e = 0; e < 16; ++e) o[e] = 0.f;
#pragma unroll
    for (int w = 0; w < 8; ++w) { const float sc = __builtin_amdgcn_exp2f(mw[w] - M); L += ((const LAS float*)(lds + w * 16384 + 14336))[2 * q + 1] * sc;
        const LAS float* op = (const LAS float*)(lds + w * 16384 + 10240);
#pragma unroll
        for (int e = 0; e < 16; ++e) o[e] += op[(16 * dq + e) * 16 + q] * sc; }
    const float inv = 1.0f / L; float ssq = 0.f;
#pragma unroll
    for (int e = 0; e < 16; ++e) { o[e] *= inv; ssq += o[e] * o[e]; }
    ssq += __shfl_xor(ssq, 16); ssq += __shfl_xor(ssq, 32);
    const float rn = __builtin_amdgcn_rsqf(ssq * (1.0f / 64.0f) + EPS);
#pragma unroll
    for (int e = 0; e < 16; ++e) o[e] *= rn;
    bf16_t* dst = MIX + (size_t)(TP + b * 16 + q) * D + h * 64 + 16 * dq;
    *(bf16x8*)dst = pack8(o); *(bf16x8*)(dst + 8) = pack8(o + 8);
}

template <bool SAMPLE>
__device__ __forceinline__ void conv_part(const Params& P, int l, int b, int c, int tid2_, int it_begin, int it_end, int nthr) {
    int tid2 = tid2_; asm volatile("" : "+v"(tid2));
    const bf16_t* Z = (const bf16_t*)(P.ws + WS_Z);
    bf16_t* MIX = (bf16_t*)(P.ws + WS_MIX);
    const bf16_t* HZC = (const bf16_t*)(P.ws + WS_HZC) + (size_t)(l * 32 + b) * 2 * 256;
    const int row0 = SAMPLE ? (TP + b * 16) : (b * SEQ + c * 64);
    const float* cw = P.in[16] + (size_t)l * 3 * 256;
#pragma unroll 2
    for (int it = it_begin + tid2; it < it_end; it += nthr) {
        const int o = it & 31, i = it >> 5, ch = 8 * o;
        const int tpos = SAMPLE ? i : (c * 64 + i);
        const bf16_t* zr = Z + (size_t)(row0 + i) * DIN;
        float bg[8], u[3][8];
        unpack8(*(const bf16x8*)(zr + 1536 + ch), bg);
#pragma unroll
        for (int k = 0; k < 3; ++k) {
            const bool ok = tpos - k >= 0;
            const bf16_t* zp = zr - (size_t)(ok ? k : 0) * DIN;
            float cg[8], hc[8]; unpack8(*(const bf16x8*)(zp + 1792 + ch), cg); unpack8(*(const bf16x8*)(zp + 2048 + ch), hc);
            float hz[8];
            if (SAMPLE) unpack8(*(const bf16x8*)(HZC + (ok ? 0 : (2 + tpos - k)) * 256 + ch), hz);
#pragma unroll
            for (int e = 0; e < 8; ++e) u[2 - k][e] = ok ? cg[e] * hc[e] : (SAMPLE ? hz[e] : 0.f);
        }
        float y[8], ssq = 0.f;
#pragma unroll
        for (int e = 0; e < 8; ++e) { y[e] = bg[e] * (cw[ch + e] * u[0][e] + cw[256 + ch + e] * u[1][e] + cw[512 + ch + e] * u[2][e]); ssq += y[e] * y[e]; }
        ssq += __shfl_xor(ssq, 1); ssq += __shfl_xor(ssq, 2); ssq += __shfl_xor(ssq, 4);
        const float rn = __builtin_amdgcn_rsqf(ssq * (1.0f / 64.0f) + EPS);
#pragma unroll
        for (int e = 0; e < 8; ++e) y[e] *= rn;
        *(bf16x8*)(MIX + (size_t)(row0 + i) * D + 512 + ch) = pack8(y);
        if (SAMPLE) { if (i >= 14) store8f(P.out + OFF_CS + ((size_t)(l * 32 + b) * 2 + (i - 14)) * 256 + ch, u[2]); }
        else { if (tpos >= SEQ - 2) store8f(P.out + OFF_CP + ((size_t)(l * 2 + b) * 2 + (tpos - (SEQ - 2))) * 256 + ch, u[2]); }
    }
}

template <bool SAMPLE, int GG>
__device__ __forceinline__ void pool_task(const Params& P, int l, int b, int c, int tb, int lane_) {
    int lane = lane_; asm volatile("" : "+v"(lane));
    constexpr int W = 2 << GG;
    const bf16_t* Z = (const bf16_t*)(P.ws + WS_Z);
    bf16_t* MIX = (bf16_t*)(P.ws + WS_MIX);
    const bf16_t* PW = (const bf16_t*)(P.ws + WS_PWT) + (size_t)(l * 4 + GG) * 4096;
    const bf16_t* HZP = (const bf16_t*)(P.ws + WS_HZP) + (size_t)(l * 32 + b) * 15 * 256 + GG * 64;
    const int r = lane & 31, hi = lane >> 5;
    const int row0 = SAMPLE ? (TP + b * 16) : (b * SEQ + c * 64);
    const int i = SAMPLE ? (r & 15) : (32 * tb + r);
    const int tpos = SAMPLE ? i : (c * 64 + i);
    const bf16_t* zr = Z + (size_t)(row0 + i) * DIN + 2304 + GG * 64 + 8 * hi;
    const float rc = 1.0f / (float)(SAMPLE ? W : (tpos + 1 < W ? tpos + 1 : W));
    bf16x8 pf[4];
#pragma unroll
    for (int ks = 0; ks < 4; ++ks) {
        bf16x8 v[W];
#pragma unroll
        for (int k = 0; k < W; ++k) {
            const int tp = tpos - k;
            const bf16_t* p = (tp >= 0) ? (zr - (size_t)k * DIN) : (SAMPLE ? (HZP + (15 + tp) * 256 + 8 * hi) : zr);
            v[k] = *(const bf16x8*)(p + 16 * ks);
        }
        float acc[8], cur[8];
        unpack8(v[0], cur);
#pragma unroll
        for (int e = 0; e < 8; ++e) acc[e] = cur[e];
#pragma unroll
        for (int k = 1; k < W; ++k) { float f[8]; unpack8(v[k], f); const bool use = SAMPLE || (tpos - k >= 0);
#pragma unroll
            for (int e = 0; e < 8; ++e) acc[e] += use ? f[e] : 0.f; }
#pragma unroll
        for (int e = 0; e < 8; ++e) acc[e] = acc[e] * rc - cur[e];
        pf[ks] = pack8(acc);
        if (SAMPLE) { if (r < 16 && i >= 1) store8f(P.out + OFF_PS + ((size_t)(l * 32 + b) * 15 + (i - 1)) * 256 + GG * 64 + 16 * ks + 8 * hi, cur); }
        else { if (tpos >= SEQ - 15) store8f(P.out + OFF_PP + ((size_t)(l * 2 + b) * 15 + (tpos - (SEQ - 15))) * 256 + GG * 64 + 16 * ks + 8 * hi, cur); }
    }
    f32x16 cc[2];
#pragma unroll
    for (int db = 0; db < 2; ++db) {
#pragma unroll
        for (int e = 0; e < 16; ++e) cc[db][e] = 0.f;
#pragma unroll
        for (int ks = 0; ks < 4; ++ks) { const bf16x8 a = *(const bf16x8*)(PW + (size_t)(32 * db + r) * 64 + 16 * ks + 8 * hi); cc[db] = __builtin_amdgcn_mfma_f32_32x32x16_bf16(a, pf[ks], cc[db], 0, 0, 0); }
    }
    float ssq = 0.f;
#pragma unroll
    for (int db = 0; db < 2; ++db)
#pragma unroll
        for (int e = 0; e < 16; ++e) ssq += cc[db][e] * cc[db][e];
    ssq += __shfl_xor(ssq, 32);
    const float rn = __builtin_amdgcn_rsqf(ssq * (1.0f / 64.0f) + EPS);
    {
        bf16_t* op = MIX + (size_t)(row0 + i) * D + 768 + GG * 64;
#pragma unroll
        for (int db = 0; db < 2; ++db) store_block32_wide(op + 32 * db, cc[db], rn, hi, !SAMPLE || r < 16);
    }
}

__device__ __forceinline__ void mixer_phase(const Params& P, int l, LAS unsigned char* lds, int G, int vcu) {
    int tid = threadIdx.x; asm volatile("" : "+v"(tid));
    const int lane = tid & 63, wave = __builtin_amdgcn_readfirstlane(tid >> 6);
    LAS unsigned char* wl = lds + wave * 16384;
    for (int u = vcu; u < 256; u += G) {
        const int b = u >> 7, c = u & 127;
        band_attn_p2(P, l, b, c, wave, wl, lane);
        const int sb = u >> 3, sh = u & 7;
        band_attn<true>(P, l, sb, 0, sh, 0, 2 * wave, wave == 7 ? 17 : 2 * wave + 2, wl, lane);
        if (wave == 0) pool_task<false, 3>(P, l, b, c, 0, lane);
        else if (wave == 1) pool_task<false, 3>(P, l, b, c, 1, lane);
        else if (wave == 2) pool_task<false, 2>(P, l, b, c, 0, lane);
        else if (wave == 3) pool_task<false, 2>(P, l, b, c, 1, lane);
        else if (wave == 4) pool_task<false, 1>(P, l, b, c, 0, lane);
        else if (wave == 5) pool_task<false, 1>(P, l, b, c, 1, lane);
        else if (wave == 6) pool_task<false, 0>(P, l, b, c, 0, lane);
        else pool_task<false, 0>(P, l, b, c, 1, lane);
        { int t2 = threadIdx.x; asm volatile("" : "+v"(t2)); conv_part<false>(P, l, b, c, t2, 0, 2048, 512); }
        __syncthreads();
        if (wave == 0) sample_merge(P, sb, sh, lds, lane);
        else if (wave == 1) { if (sh == 0) pool_task<true, 0>(P, l, sb, 0, 0, lane); else if (sh == 1) pool_task<true, 1>(P, l, sb, 0, 0, lane);
                              else if (sh == 2) pool_task<true, 2>(P, l, sb, 0, 0, lane); else if (sh == 3) pool_task<true, 3>(P, l, sb, 0, 0, lane); }
        else if (wave < 4) { if (sh >= 4) { int t2 = threadIdx.x; asm volatile("" : "+v"(t2)); conv_part<true>(P, l, sb, 0, t2 - 128, (sh - 4) * 128, (sh - 4) * 128 + 128, 128); } }
        __syncthreads();
    }
}

__device__ __forceinline__ int voff_x(int key, int d) { return ((key >> 3) * 8 + (d >> 5)) * 512 + (key & 7) * 64 + (d & 31) * 2; }
__device__ __forceinline__ int koff_x(int mem, int chunk) { return mem * 512 + ((chunk ^ (mem & 15)) << 4); }

__device__ __forceinline__ void xattn_prompt_unit(const Params& P, int l, int qt, int h, LAS unsigned char* lds, int tid_) {
    int tid = tid_; asm volatile("" : "+v"(tid));
    const int lane = tid & 63, wave = __builtin_amdgcn_readfirstlane(tid >> 6), r = lane & 31, hi = lane >> 5;
    const int b = qt >> 5;
    const bf16_t* Q2 = (const bf16_t*)(P.ws + WS_Q2);
    bf16_t* O2 = (bf16_t*)(P.ws + WS_O2);
    const bf16_t* MK = (const bf16_t*)(P.ws + WS_MEMKV) + ((size_t)(2 * l) * 512 + b * 256) * 1024 + h * 256;
    const bf16_t* MV = (const bf16_t*)(P.ws + WS_MEMKV) + ((size_t)(2 * l + 1) * 512 + b * 256) * 1024 + h * 256;
    const int qrow = qt * 256 + wave * 32 + r;
    const int sm0 = tid >> 5, sc0 = tid & 31;
    const unsigned gsrc = (unsigned)(sm0 * 1024 + sc0 * 8);
    bf16x8 stg[2];
    stg[0] = *(const bf16x8*)(MK + gsrc); stg[1] = *(const bf16x8*)(MK + gsrc + 16 * 1024);
    bf16x8 qf[16];
#pragma unroll
    for (int ks = 0; ks < 16; ++ks) qf[ks] = *(const bf16x8*)(Q2 + (size_t)qrow * D + h * 256 + 16 * ks + 8 * hi);
    *(LAS bf16x8*)(lds + koff_x(sm0, sc0)) = stg[0]; *(LAS bf16x8*)(lds + koff_x(sm0 + 16, sc0)) = stg[1];
    __syncthreads();
    f32x16 S[8];
#pragma unroll
    for (int s = 0; s < 8; ++s) {
        LAS unsigned char* cur = lds + (s & 1) * 16384; LAS unsigned char* nxt = lds + ((s + 1) & 1) * 16384;
        const bf16_t* src = (s < 7) ? MK + (size_t)(s + 1) * 32 * 1024 : MV;
        stg[0] = *(const bf16x8*)(src + gsrc); stg[1] = *(const bf16x8*)(src + gsrc + 16 * 1024);
#pragma unroll
        for (int e = 0; e < 16; ++e) S[s][e] = 0.f;
#pragma unroll
        for (int ks = 0; ks < 16; ++ks) { const bf16x8 kf = *(const LAS bf16x8*)(cur + koff_x(r, 2 * ks + hi)); S[s] = __builtin_amdgcn_mfma_f32_32x32x16_bf16(kf, qf[ks], S[s], 0, 0, 0); }
        if (s < 7) { *(LAS bf16x8*)(nxt + koff_x(sm0, sc0)) = stg[0]; *(LAS bf16x8*)(nxt + koff_x(sm0 + 16, sc0)) = stg[1]; }
        else { *(LAS bf16x8*)(nxt + voff_x(sm0, 8 * sc0)) = stg[0]; *(LAS bf16x8*)(nxt + voff_x(sm0 + 16, 8 * sc0)) = stg[1]; }
        __syncthreads();
    }
    float mx = S[0][0];
#pragma unroll
    for (int s = 0; s < 8; ++s)
#pragma unroll
        for (int e = 0; e < 16; ++e) mx = fmaxf(mx, S[s][e]);
    mx = fmaxf(mx, __shfl_xor(mx, 32));
    float lsum = 0.f;
    bf16x8 pf[8][2];
#pragma unroll
    for (int s = 0; s < 8; ++s) {
#pragma unroll
        for (int e = 0; e < 16; ++e) { S[s][e] = __builtin_amdgcn_exp2f(S[s][e] - mx); lsum += S[s][e]; }
#pragma unroll
        for (int s2 = 0; s2 < 2; ++s2) { u32x4 w; w.x = cvt_pk_bf16(S[s][8 * s2 + 0], S[s][8 * s2 + 1]); w.y = cvt_pk_bf16(S[s][8 * s2 + 2], S[s][8 * s2 + 3]); w.z = cvt_pk_bf16(S[s][8 * s2 + 4], S[s][8 * s2 + 5]); w.w = cvt_pk_bf16(S[s][8 * s2 + 6], S[s][8 * s2 + 7]);
            pf[s][s2] = __builtin_bit_cast(bf16x8, w); }
    }
    lsum += __shfl_xor(lsum, 32);
    f32x16 O[8];
#pragma unroll
    for (int db = 0; db < 8; ++db)
#pragma unroll
        for (int e = 0; e < 16; ++e) O[db][e] = 0.f;
    const int trow = 4 * hi + ((lane & 15) >> 2), tcol = 16 * ((lane >> 4) & 1) + 4 * (lane & 3);
#pragma unroll
    for (int s = 8; s < 16; ++s) {
        LAS unsigned char* cur = lds + (s & 1) * 16384; LAS unsigned char* nxt = lds + ((s + 1) & 1) * 16384;
        if (s < 15) { const bf16_t* src = MV + (size_t)(s - 7) * 32 * 1024; stg[0] = *(const bf16x8*)(src + gsrc); stg[1] = *(const bf16x8*)(src + gsrc + 16 * 1024); }
#pragma unroll
        for (int db = 0; db < 8; ++db)
#pragma unroll
            for (int s2 = 0; s2 < 2; ++s2) {
                const s16x4 a0 = tr_read(cur + voff_x(16 * s2 + trow, 32 * db + tcol));
                const s16x4 a1 = tr_read(cur + voff_x(16 * s2 + 8 + trow, 32 * db + tcol));
                const bf16x8 vf = (bf16x8){a0[0], a0[1], a0[2], a0[3], a1[0], a1[1], a1[2], a1[3]};
                O[db] = __builtin_amdgcn_mfma_f32_32x32x16_bf16(vf, pf[s - 8][s2], O[db], 0, 0, 0);
            }
        if (s < 15) { *(LAS bf16x8*)(nxt + voff_x(sm0, 8 * sc0)) = stg[0]; *(LAS bf16x8*)(nxt + voff_x(sm0 + 16, 8 * sc0)) = stg[1]; }
        __syncthreads();
    }
    const float inv = 1.0f / lsum;
    bf16_t* op = O2 + (size_t)qrow * D + h * 256;
#pragma unroll
    for (int db = 0; db < 8; ++db) store_block32_wide(op + 32 * db, O[db], inv, hi, true);
}

__device__ __forceinline__ void xattn_sample_unit(const Params& P, int l, int b, int h, LAS unsigned char* lds, int tid_) {
    int tid = tid_; asm volatile("" : "+v"(tid));
    const int lane = tid & 63, wave = __builtin_amdgcn_readfirstlane(tid >> 6), r = lane & 31, hi = lane >> 5;
    const bf16_t* Q2 = (const bf16_t*)(P.ws + WS_Q2);
    bf16_t* O2 = (bf16_t*)(P.ws + WS_O2);
    const float* CK = P.in[7] + ((size_t)(l * 32 + b) * 256 + 32 * wave) * 1024 + h * 256;
    const float* CV = P.in[8] + ((size_t)(l * 32 + b) * 256 + 32 * wave) * 1024 + h * 256;
    LAS unsigned char* wl = lds + wave * 16384;
    LAS float* ml = (LAS float*)(lds + 131072);
    const int qrow = TP + b * 16 + (r & 15);
#pragma unroll 4
    for (int i = 0; i < 16; ++i) { const int idx = lane + 64 * i, vr = idx >> 5, ch = idx & 31;
        *(LAS bf16x8*)(wl + voff_x(vr, 8 * ch)) = load8f_bf(CV + (size_t)vr * 1024 + 8 * ch); }
    f32x16 S;
#pragma unroll
    for (int e = 0; e < 16; ++e) S[e] = 0.f;
#pragma unroll 4
    for (int ks = 0; ks < 16; ++ks) {
        const bf16x8 qf = *(const bf16x8*)(Q2 + (size_t)qrow * D + h * 256 + 16 * ks + 8 * hi);
        const bf16x8 kf = load8f_bf(CK + (size_t)r * 1024 + 16 * ks + 8 * hi);
        S = __builtin_amdgcn_mfma_f32_32x32x16_bf16(kf, qf, S, 0, 0, 0);
    }
    float mx = S[0];
#pragma unroll
    for (int e = 1; e < 16; ++e) mx = fmaxf(mx, S[e]);
    mx = fmaxf(mx, __shfl_xor(mx, 32));
    float ls = 0.f;
#pragma unroll
    for (int e = 0; e < 16; ++e) { S[e] = __builtin_amdgcn_exp2f(S[e] - mx); ls += S[e]; }
    ls += __shfl_xor(ls, 32);
    bf16x8 pf[2];
#pragma unroll
    for (int s2 = 0; s2 < 2; ++s2) { u32x4 w; w.x = cvt_pk_bf16(S[8 * s2 + 0], S[8 * s2 + 1]); w.y = cvt_pk_bf16(S[8 * s2 + 2], S[8 * s2 + 3]); w.z = cvt_pk_bf16(S[8 * s2 + 4], S[8 * s2 + 5]); w.w = cvt_pk_bf16(S[8 * s2 + 6], S[8 * s2 + 7]);
        pf[s2] = __builtin_bit_cast(bf16x8, w); }
    f32x16 O[8];
    const int trow = 4 * hi + ((lane & 15) >> 2), tcol = 16 * ((lane >> 4) & 1) + 4 * (lane & 3);
#pragma unroll
    for (int db = 0; db < 8; ++db) {
#pragma unroll
        for (int e = 0; e < 16; ++e) O[db][e] = 0.f;
#pragma unroll
        for (int s2 = 0; s2 < 2; ++s2) {
            const s16x4 a0 = tr_read(wl + voff_x(16 * s2 + trow, 32 * db + tcol));
            const s16x4 a1 = tr_read(wl + voff_x(16 * s2 + 8 + trow, 32 * db + tcol));
            const bf16x8 vf = (bf16x8){a0[0], a0[1], a0[2], a0[3], a1[0], a1[1], a1[2], a1[3]};
            O[db] = __builtin_amdgcn_mfma_f32_32x32x16_bf16(vf, pf[s2], O[db], 0, 0, 0);
        }
    }
    if (lane < 16) { ml[(wave * 16 + lane) * 2] = mx; ml[(wave * 16 + lane) * 2 + 1] = ls; }
    if (r < 16) {
        LAS float* ow = (LAS float*)wl;
#pragma unroll
        for (int db = 0; db < 8; ++db)
#pragma unroll
            for (int e = 0; e < 16; ++e) ow[(32 * db + (e & 3) + 8 * (e >> 2) + 4 * hi) * 16 + r] = O[db][e];
    }
    __syncthreads();
    {
        const int q = tid & 15, dg = tid >> 4;
        float mw[8], M = -1e30f;
#pragma unroll
        for (int w = 0; w < 8; ++w) { mw[w] = ml[(w * 16 + q) * 2]; M = fmaxf(M, mw[w]); }
        float L = 0.f, o[8];
#pragma unroll
        for (int e = 0; e < 8; ++e) o[e] = 0.f;
#pragma unroll
        for (int w = 0; w < 8; ++w) { const float sc = __builtin_amdgcn_exp2f(mw[w] - M); L += ml[(w * 16 + q) * 2 + 1] * sc;
            const LAS float* ow = (const LAS float*)(lds + w * 16384);
#pragma unroll
            for (int e = 0; e < 8; ++e) o[e] += ow[(8 * dg + e) * 16 + q] * sc; }
        const float inv = 1.0f / L;
#pragma unroll
        for (int e = 0; e < 8; ++e) o[e] *= inv;
        *(bf16x8*)(O2 + (size_t)(TP + b * 16 + q) * D + h * 256 + 8 * dg) = pack8(o);
    }
    __syncthreads();
}

__device__ __forceinline__ void xattn_phase(const Params& P, int l, LAS unsigned char* lds, int G, int vcu) {
    for (int u = vcu; u < 256; u += G) { xattn_prompt_unit(P, l, u >> 2, u & 3, lds, threadIdx.x); __syncthreads(); }
    for (int u = vcu; u < 128; u += G) xattn_sample_unit(P, l, u >> 2, u & 3, lds, threadIdx.x);
}

#define XB_TMO      128
#define XB_XCNT(j)  (256  + 64 * (j))
#define XB_XSUB(j)  (1280 + 64 * (j))
#define XB_XGEN(j)  (2304 + 64 * (j))
#define XB_TOP      3328
#define XB_TOPGEN   3392
#define XCD_BAR_WORDS 3456
#define XB_SPIN_CAP (1u << 22)
__device__ __forceinline__ unsigned xb_ld(unsigned* p)              { return __hip_atomic_load(p, __ATOMIC_RELAXED, __HIP_MEMORY_SCOPE_AGENT); }
__device__ __forceinline__ unsigned xb_add(unsigned* p, unsigned v) { return __hip_atomic_fetch_add(p, v, __ATOMIC_RELAXED, __HIP_MEMORY_SCOPE_AGENT); }
__device__ __forceinline__ unsigned xb_xcc_id() { return (unsigned)__builtin_amdgcn_s_getreg((3 << 11) | 20) & 0xFu; }
#define XB_SPIN(cond, bar) do { unsigned _sp = 0; while (cond) { __builtin_amdgcn_s_sleep(1); \
    if ((++_sp & 255u) == 0u) { if (xb_ld(&(bar)[XB_TMO])) break; if (_sp > XB_SPIN_CAP) { atomicAdd(&(bar)[XB_TMO], 1u); break; } } } } while (0)
struct XcdBarrier { unsigned* bar; unsigned x; volatile LAS unsigned* st; };
__device__ __forceinline__ XcdBarrier xcd_barrier_post(unsigned* bar, volatile LAS unsigned* st) {
    XcdBarrier b; b.bar = bar; b.x = xb_xcc_id(); b.st = st;
    if (threadIdx.x == 0) (void)xb_add(&bar[XB_XCNT(b.x)], 1u);
    return b;
}
__device__ __forceinline__ void xcd_barrier_complete(unsigned* bar, unsigned x, unsigned& nloc, unsigned& nx) {
    const unsigned G = gridDim.x * gridDim.y * gridDim.z;
    unsigned sum, cnt, mine, sp = 0u;
    for (;;) {
        sum = 0u; cnt = 0u; mine = 0u;
#pragma unroll
        for (unsigned j = 0; j < 16; ++j) { const unsigned c = xb_ld(&bar[XB_XCNT(j)]); sum += c; cnt += (c > 0u) ? 1u : 0u; mine = (j == x) ? c : mine; }
        if (sum == G) break;
        __builtin_amdgcn_s_sleep(1);
        if ((++sp & 255u) == 0u) { if (xb_ld(&bar[XB_TMO])) break; if (sp > XB_SPIN_CAP) { atomicAdd(&bar[XB_TMO], 1u); break; } }
    }
    nloc = mine > 0u ? mine : 1u; nx = cnt > 0u ? cnt : 1u;
}
__device__ __forceinline__ void xcd_barrier(const XcdBarrier& b) {
    asm volatile("s_waitcnt vmcnt(0)" ::: "memory");
    __syncthreads();
    if (threadIdx.x == 0) {
        unsigned* bar = b.bar; unsigned bx_ = b.x; asm volatile("" : "+s"(bar), "+s"(bx_));
        __builtin_amdgcn_s_waitcnt(0);
        unsigned nloc = b.st[0], nx = b.st[1];
        if (nloc == 0u) { xcd_barrier_complete(bar, bx_, nloc, nx); b.st[0] = nloc; b.st[1] = nx; }
        const unsigned old = xb_add(&bar[XB_XSUB(bx_)], 1u);
        const unsigned gen = old / nloc;
        if (old + 1u == (gen + 1u) * nloc) {
            __builtin_amdgcn_fence(__ATOMIC_RELEASE, "agent");
            asm volatile("s_waitcnt vmcnt(0)" ::: "memory");
            const unsigned og = xb_add(&bar[XB_TOP], 1u);
            const unsigned tg = og / nx;
            if (og + 1u == (tg + 1u) * nx) xb_add(&bar[XB_TOPGEN], 1u);
            else XB_SPIN(xb_ld(&bar[XB_TOPGEN]) == tg, bar);
            __builtin_amdgcn_fence(__ATOMIC_ACQUIRE, "agent");
            xb_add(&bar[XB_XGEN(bx_)], 1u);
            asm volatile("s_waitcnt vmcnt(0)" ::: "memory");
        } else {
            XB_SPIN(xb_ld(&bar[XB_XGEN(bx_)]) == gen, bar);
            __builtin_amdgcn_fence(__ATOMIC_ACQUIRE, "agent");
            asm volatile("s_waitcnt vmcnt(0)" ::: "memory");
        }
    }
    __syncthreads();
}

__global__ void __launch_bounds__(512, 2) mega_fwd(Params P) {
    extern __shared__ __attribute__((aligned(16))) unsigned char lds_raw[];
    LAS unsigned char* lds = (LAS unsigned char*)lds_raw;
    cg::grid_group grid = cg::this_grid();
    const int G = gridDim.x, bx = blockIdx.x;
    const int vcu = (G % 8 == 0) ? (bx % 8) * (G / 8) + bx / 8 : bx;
    unsigned char* ws0 = P.ws;

    volatile LAS unsigned* bst = (volatile LAS unsigned*)(lds + 131072 + 8192);
    if (threadIdx.x < 2) bst[threadIdx.x] = 0u;
    __syncthreads();
    XcdBarrier xbar = xcd_barrier_post((unsigned*)(ws0 + WS_CTL), bst);
    prologue(P, lds, G, vcu);
    if (P.ws == nullptr) grid.sync();
    xcd_barrier(xbar);

    for (int step = 0; step < 36; ++step) {
        const int l = step / 9; int s = step % 9; if (s >= 6) ++s;
        unsigned char* ws = ws0; asm volatile("" : "+s"(ws));
        int bxs = bx; asm volatile("" : "+s"(bxs));
        float* X = (float*)(ws + WS_X); bf16_t* XB = (bf16_t*)(ws + WS_XB); float* SS = (float*)(ws + WS_SS);
        bf16_t* ACT = (bf16_t*)(ws + WS_ACT); bf16_t* Z = (bf16_t*)(ws + WS_Z); bf16_t* MIX = (bf16_t*)(ws + WS_MIX);
        bf16_t* Q2 = (bf16_t*)(ws + WS_Q2); bf16_t* O2 = (bf16_t*)(ws + WS_O2);
        if (s == 0 || s == 8) {
            const int f = 2 * l + (s == 8);
            pg8::Gemm g{XB, (const bf16_t*)(ws + WS_W1) + (size_t)f * 2 * DFF * D, T, 2 * DFF, D};
            pg8::StaticOrder S; S.init(T, 2 * DFF, G, bxs);
            pg8::EpiSwiglu E{ACT};
            pg8::gemm_phase(lds, g, S, E, SS);
        }
        if (s == 2 || s == 5 || step == 0) {
            pg8::Gemm g; pg8::StaticOrder S; pg8::EpiScale E; const float* ssp = SS;
            if (step == 0) { ssp = (const float*)(ws + WS_SSM); g = pg8::Gemm{(const bf16_t*)(ws + WS_MEMB), (const bf16_t*)(ws + WS_WKV), 512, 8192, D}; S.init(512, 8192, G, (bxs + 64) % G);
                E = pg8::EpiScale{(bf16_t*)(ws + WS_MEMKV), 1024, 1.0f, 1, P.out + OFF_MK}; }
            else if (s == 2) { g = pg8::Gemm{XB, (const bf16_t*)(ws + WS_WIN) + (size_t)l * DIN * D, T, DIN, D}; S.init(T, DIN, G, bxs);
                E = pg8::EpiScale{Z, DIN, 1.0f, 0, nullptr}; }
            else { g = pg8::Gemm{XB, (const bf16_t*)(ws + WS_WXQ) + (size_t)l * D * D, TP, D, D}; S.init(TP, D, G, bxs);
                E = pg8::EpiScale{Q2, D, 0.0625f * LOG2E, 0, nullptr}; }
            pg8::gemm_phase(lds, g, S, E, ssp);
            if (s == 5) {
                asm volatile("s_waitcnt vmcnt(0)" ::: "memory"); __syncthreads();
                pg8::Unit uq;
                for (int i = 0; S.next(i, uq); ++i) { xattn_prompt_unit(P, l, uq.pm, uq.pn, lds, threadIdx.x); __syncthreads(); }
                for (int u = bxs; u < 128; u += G) {
                    small_gemm_q256(lds, g.A, g.Bt, u, SS, 0.0625f * LOG2E, Q2);
                    xattn_sample_unit(P, l, u >> 2, u & 3, lds, threadIdx.x);
                }
            }
        }
        if (s == 1 || s == 9 || s == 4 || s == 7) {
            pg8::Gemm g; float sc = 1.0f;
            if (s == 1 || s == 9) { g = pg8::Gemm{ACT, (const bf16_t*)(ws + WS_WD) + (size_t)(2 * l + (s == 9)) * D * DFF, TP, D, DFF}; sc = 0.5f; }
            else if (s == 4) g = pg8::Gemm{MIX, (const bf16_t*)(ws + WS_WOUT) + (size_t)l * D * D, TP, D, D};
            else g = pg8::Gemm{O2, (const bf16_t*)(ws + WS_WXO) + (size_t)l * D * D, TP, D, D};
            pg8::StaticOrder S; S.init(TP, D, G, bxs);
            pg8::EpiResid E{X, XB, SS, sc};
            pg8::gemm_phase(lds, g, S, E, nullptr);
            for (int u = bxs; u < 256; u += G) small_gemm_res(lds, g.A, g.Bt, g.K, u, XB, SS, sc);
        }
        if (s == 0 || s == 2 || (s == 8 && l < NL - 1)) {
            const int cl = s == 8 ? l + 1 : l, p0 = s == 8 ? 0 : (s == 0 ? (step == 0 ? 0 : 30) : 60), p1 = s == 8 ? 30 : (s == 0 ? 60 : 100);
            int c0 = s == 2 ? 148 : 172; if (G <= c0) c0 = 0;
            if (bxs >= c0) cache_convert(P, cl, p0, p1, bxs - c0, G - c0);
        }
#ifndef NO_MIXER
        if (s == 3) mixer_phase(P, l, lds, G, vcu);
#endif
        xcd_barrier(xbar);
    }
    {
        int tid = threadIdx.x; asm volatile("" : "+v"(tid));
        const int lane = tid & 63, wave = tid >> 6;
        const float* X = (const float*)(ws0 + WS_X);
        const float* gf = P.in[31];
        for (int m = vcu * NW + wave; m < T; m += G * NW) {
            const u32x2* xr = (const u32x2*)((const bf16_t*)(ws0 + WS_XB) + (size_t)m * D);
            f32x4 v[4]; float ss = 0.f;
#pragma unroll
            for (int j = 0; j < 4; ++j) { const u32x2 xw = xr[lane + 64 * j]; v[j] = (f32x4){bf_lo(xw.x), bf_hi(xw.x), bf_lo(xw.y), bf_hi(xw.y)}; ss += (v[j][0] * v[j][0] + v[j][1] * v[j][1]) + (v[j][2] * v[j][2] + v[j][3] * v[j][3]); }
            ss = wave_sum(ss);
            const float rs = __builtin_amdgcn_rsqf(ss * (1.0f / 1024.0f) + EPS);
#pragma unroll
            for (int j = 0; j < 4; ++j) { const f32x4 gg = ((const f32x4*)gf)[lane + 64 * j]; ((f32x4*)(P.out + OFF_Y + (size_t)m * D))[lane + 64 * j] = v[j] * rs * gg; }
        }
    }
}

constexpr int LDS_BYTES = 131072 + 8192 + 64;
extern "C" void kernel_launch(void* const* d_in, const int* in_sizes, int n_in, void* d_out, int out_size, void* d_ws, size_t ws_size, hipStream_t stream) {
    static int grid = 0;
    if (grid == 0) {
        if (n_in != 32 || (size_t)out_size != OUT_TOTAL || ws_size < WS_END) { fprintf(stderr, "kernel_launch: unexpected sizes n_in %d out %d ws %zu (need %zu)\n", n_in, out_size, ws_size, (size_t)WS_END); grid = -1; return; }
        int dev = 0, cus = 0, per_cu = 0;
        hipGetDevice(&dev);
        hipDeviceGetAttribute(&cus, hipDeviceAttributeMultiprocessorCount, dev);
        if (hipFuncSetAttribute((const void*)mega_fwd, hipFuncAttributeMaxDynamicSharedMemorySize, LDS_BYTES) != hipSuccess) { fprintf(stderr, "kernel_launch: hipFuncSetAttribute failed\n"); grid = -1; return; }
        if (hipOccupancyMaxActiveBlocksPerMultiprocessor(&per_cu, (const void*)mega_fwd, 512, LDS_BYTES) != hipSuccess || per_cu < 1) { fprintf(stderr, "kernel_launch: occupancy query says %d\n", per_cu); per_cu = 1; }
        (void)hipGetLastError();
        grid = cus;
    }
    if (grid < 0) return;
    if (hipMemsetAsync((char*)d_ws + WS_CTL, 0, 16384, stream) != hipSuccess) { fprintf(stderr, "kernel_launch: memset failed\n"); return; }
    Params p{};
    for (int i = 0; i < 32; ++i) p.in[i] = (const float*)d_in[i];
    p.out = (float*)d_out; p.ws = (unsigned char*)d_ws;
    void* args[] = {&p};
    hipError_t e = hipLaunchCooperativeKernel((const void*)mega_fwd, dim3(grid), dim3(512), args, LDS_BYTES, stream);
    if (e != hipSuccess) fprintf(stderr, "cooperative launch failed: %s (grid %d)\n", hipGetErrorString(e), grid);
}
```
